# Optimizing an MI355X kernel written in HIP

```python
import jax, jax.numpy as jnp
from jax import lax
import numpy as np

D_MODEL = 2048
BATCH = 1
SEQ = 16384
DEPTH = 1

HEAD_DIM = 128
ATTN_GROUPS = ((128, 1), (512, 4), (2048, 16))
HEADS_PER_GROUP = 4
N_ATTN_HEADS = HEADS_PER_GROUP * len(ATTN_GROUPS)
ATTN_WIDTH = N_ATTN_HEADS * HEAD_DIM
ATTN_OUT_WIDTH = HEADS_PER_GROUP * HEAD_DIM
ROPE_THETA = 10000.0
POOL_WINDOWS = (2, 4, 8, 16)
POOL_GROUP_DIM = D_MODEL // 8
POOL_WIDTH = len(POOL_WINDOWS) * POOL_GROUP_DIM
N_MEM = 256
MEM_HEADS = 4
MEM_HEAD_DIM = D_MODEL // 8
MEM_WIDTH = MEM_HEADS * MEM_HEAD_DIM
N_BRANCHES = 3
IN_COLS = POOL_WIDTH + 3 * ATTN_WIDTH + MEM_WIDTH + N_BRANCHES * D_MODEL
D_FF = 5632
EPS = 1e-6
NEG = -1e30

kernel_name = "hybrid_gated_pool_dilated_mem_encoder"


def rmsnorm(x, g):
    xf = x.astype(jnp.float32)
    y = xf * lax.rsqrt(jnp.mean(xf * xf, axis=-1, keepdims=True) + EPS)
    return (y * g.astype(jnp.float32)).astype(x.dtype)


def swiglu(x, w_gate, w_up, w_down):
    return (jax.nn.silu(x @ w_gate) * (x @ w_up)) @ w_down


def rope(t, positions):
    dh = t.shape[-1]
    half = dh // 2
    inv_freq = ROPE_THETA ** (-jnp.arange(half, dtype=jnp.float32) / half)
    ang = positions.astype(jnp.float32)[..., None] * inv_freq
    cos = jnp.cos(ang)[:, :, None, :]
    sin = jnp.sin(ang)[:, :, None, :]
    tf = t.astype(jnp.float32)
    t1, t2 = tf[..., :half], tf[..., half:]
    out = jnp.concatenate([t1 * cos - t2 * sin, t2 * cos + t1 * sin], axis=-1)
    return out.astype(t.dtype)


def band_attention(q, k, v, key_valid, half_span):
    B, N, H, Dh = q.shape
    blk = half_span
    nb = N // blk

    def with_halo(t):
        t = t.reshape((B, nb, blk) + t.shape[2:])
        tp = jnp.pad(t, [(0, 0), (1, 1)] + [(0, 0)] * (t.ndim - 2))
        return jnp.concatenate([tp[:, :-2], tp[:, 1:-1], tp[:, 2:]], axis=2)

    qb = q.reshape(B, nb, blk, H, Dh)
    kb, vb, vk = with_halo(k), with_halo(v), with_halo(key_valid)
    s = jnp.einsum('bnqhd,bnkhd->bnhqk', qb, kb).astype(jnp.float32) * (Dh ** -0.5)
    rel = jnp.arange(3 * blk)[None, :] - blk - jnp.arange(blk)[:, None]
    allowed = (jnp.abs(rel) <= half_span)[None, None, None] & vk[:, :, None, None, :]
    s = jnp.where(allowed, s, NEG)
    lse = jax.nn.logsumexp(s, axis=-1)
    p = jnp.exp(s - lse[..., None]).astype(v.dtype)
    o = jnp.einsum('bnhqk,bnkhd->bnqhd', p, vb).reshape(B, N, H, Dh)
    lse = jnp.transpose(lse, (0, 1, 3, 2)).reshape(B, N, H)
    return o, lse


def dilated_window_group(q, k, v, window, dilation):
    B, S, H, Dh = q.shape
    half_span = window // (2 * dilation)
    unit = dilation * half_span
    Sp = -(-S // unit) * unit
    L = Sp // dilation
    valid = jnp.broadcast_to(jnp.arange(Sp) < S, (B, Sp))

    def to_sub(t):
        if t.shape[1] != Sp:
            t = jnp.pad(t, [(0, 0), (0, Sp - t.shape[1])] + [(0, 0)] * (t.ndim - 2))
        t = jnp.moveaxis(t.reshape((B, L, dilation) + t.shape[2:]), 2, 1)
        return t.reshape((B * dilation, L) + t.shape[3:])

    def from_sub(t):
        t = jnp.moveaxis(t.reshape((B, dilation, L) + t.shape[2:]), 1, 2)
        return t.reshape((B, Sp) + t.shape[3:])[:, :S]

    o, lse = band_attention(to_sub(q), to_sub(k), to_sub(v), to_sub(valid), half_span)
    return from_sub(o), from_sub(lse)


def dilated_attention_branch(q, k, v, positions):
    B, S, _ = q.shape
    q = rope(q.reshape(B, S, N_ATTN_HEADS, HEAD_DIM), positions)
    k = rope(k.reshape(B, S, N_ATTN_HEADS, HEAD_DIM), positions)
    v = v.reshape(B, S, N_ATTN_HEADS, HEAD_DIM)
    outs, lses = [], []
    for g, (window, dilation) in enumerate(ATTN_GROUPS):
        hs = slice(g * HEADS_PER_GROUP, (g + 1) * HEADS_PER_GROUP)
        o, lse = dilated_window_group(q[:, :, hs], k[:, :, hs], v[:, :, hs], window, dilation)
        outs.append(o)
        lses.append(lse)
    w = jax.nn.softmax(jnp.stack(lses, axis=0), axis=0)
    o = jnp.sum(w[..., None].astype(q.dtype) * jnp.stack(outs, axis=0), axis=0)
    return o.reshape(B, S, ATTN_OUT_WIDTH)


def centred_mean_minus_self(u, window):
    B, S, C = u.shape
    half = window // 2
    cs = jnp.concatenate([jnp.zeros((B, 1, C), u.dtype), lax.cumsum(u, axis=1)], axis=1)
    idx = jnp.arange(S)
    lo = jnp.clip(idx - half, 0, S)
    hi = jnp.clip(idx + half + 1, 0, S)
    cnt = (hi - lo).astype(u.dtype)
    return (cs[:, hi] - cs[:, lo]) / cnt[None, :, None] - u


def pooling_branch(u, pool_w, pool_scale):
    B, S, _ = u.shape
    uf = u.astype(jnp.float32).reshape(B, S, len(POOL_WINDOWS), POOL_GROUP_DIM)
    pooled = jnp.stack([centred_mean_minus_self(uf[:, :, g], w)
                        for g, w in enumerate(POOL_WINDOWS)], axis=2).astype(u.dtype)
    mixed = jnp.einsum('bsgc,gcd->bsgd', pooled, pool_w).reshape(B, S, POOL_WIDTH)
    return mixed * pool_scale


def memory_branch(q_mem, mem_n, w_mem_kv):
    B, S, _ = q_mem.shape
    kv = mem_n @ w_mem_kv
    k_m = kv[..., :MEM_WIDTH].reshape(B, -1, MEM_HEADS, MEM_HEAD_DIM)
    v_m = kv[..., MEM_WIDTH:].reshape(B, -1, MEM_HEADS, MEM_HEAD_DIM)
    q = q_mem.reshape(B, S, MEM_HEADS, MEM_HEAD_DIM)
    s = jnp.einsum('bshd,bmhd->bhsm', q, k_m).astype(jnp.float32) * (MEM_HEAD_DIM ** -0.5)
    p = jax.nn.softmax(s, axis=-1).astype(v_m.dtype)
    return jnp.einsum('bhsm,bmhd->bshd', p, v_m).reshape(B, S, MEM_WIDTH)


def setup_inputs(seed: int = 0) -> dict:
    key = jax.random.key(seed)
    ks = iter(jax.random.split(key, 32))
    L = DEPTH

    def w(shape, fan_in):
        return jax.random.normal(next(ks), shape, jnp.float32) * fan_in ** -0.5

    def gain(shape):
        return 1.0 + 0.02 * jax.random.normal(next(ks), shape, jnp.float32)

    return {
        "x": jax.random.normal(next(ks), (BATCH, SEQ, D_MODEL), jnp.float32),
        "mem": jax.random.normal(next(ks), (BATCH, N_MEM, D_MODEL), jnp.float32),
        "positions": jnp.broadcast_to(jnp.arange(SEQ, dtype=jnp.int32), (BATCH, SEQ)),
        "ffn1_norm": gain((L, D_MODEL)),
        "ffn1_w_gate": w((L, D_MODEL, D_FF), D_MODEL),
        "ffn1_w_up": w((L, D_MODEL, D_FF), D_MODEL),
        "ffn1_w_down": w((L, D_FF, D_MODEL), D_FF),
        "mix_norm": gain((L, D_MODEL)),
        "w_in": w((L, D_MODEL, IN_COLS), D_MODEL),
        "b_gate": 0.01 * jax.random.normal(next(ks), (L, N_BRANCHES * D_MODEL), jnp.float32),
        "pool_w": w((L, len(POOL_WINDOWS), POOL_GROUP_DIM, POOL_GROUP_DIM), POOL_GROUP_DIM),
        "pool_scale": gain((L, POOL_WIDTH)),
        "mem_norm": gain((L, D_MODEL)),
        "w_mem_kv": w((L, D_MODEL, 2 * MEM_WIDTH), D_MODEL),
        "w_up_pool": w((L, POOL_WIDTH, D_MODEL), POOL_WIDTH),
        "w_up_attn": w((L, ATTN_OUT_WIDTH, D_MODEL), ATTN_OUT_WIDTH),
        "w_up_mem": w((L, MEM_WIDTH, D_MODEL), MEM_WIDTH),
        "w_out": w((L, D_MODEL, D_MODEL), D_MODEL),
        "ffn2_norm": gain((L, D_MODEL)),
        "ffn2_w_gate": w((L, D_MODEL, D_FF), D_MODEL),
        "ffn2_w_up": w((L, D_MODEL, D_FF), D_MODEL),
        "ffn2_w_down": w((L, D_FF, D_MODEL), D_FF),
        "final_norm": gain((D_MODEL,)),
    }


def reference(x, mem, positions, ffn1_norm, ffn1_w_gate, ffn1_w_up, ffn1_w_down,
              mix_norm, w_in, b_gate, pool_w, pool_scale, mem_norm, w_mem_kv,
              w_up_pool, w_up_attn, w_up_mem, w_out,
              ffn2_norm, ffn2_w_gate, ffn2_w_up, ffn2_w_down, final_norm):
    c1 = POOL_WIDTH
    c2 = c1 + ATTN_WIDTH
    c3 = c2 + ATTN_WIDTH
    c4 = c3 + ATTN_WIDTH
    c5 = c4 + MEM_WIDTH
    for l in range(DEPTH):
        x = x + 0.5 * swiglu(rmsnorm(x, ffn1_norm[l]), ffn1_w_gate[l], ffn1_w_up[l], ffn1_w_down[l])
        h = rmsnorm(x, mix_norm[l])
        proj = h @ w_in[l]
        u_pool = proj[..., :c1]
        q, k, v = proj[..., c1:c2], proj[..., c2:c3], proj[..., c3:c4]
        q_mem = proj[..., c4:c5]
        gates = jax.nn.sigmoid(proj[..., c5:] + b_gate[l])
        y_pool = pooling_branch(u_pool, pool_w[l], pool_scale[l]) @ w_up_pool[l]
        y_attn = dilated_attention_branch(q, k, v, positions) @ w_up_attn[l]
        y_mem = memory_branch(q_mem, rmsnorm(mem, mem_norm[l]), w_mem_kv[l]) @ w_up_mem[l]
        merged = (gates[..., :D_MODEL] * y_pool
                  + gates[..., D_MODEL:2 * D_MODEL] * y_attn
                  + gates[..., 2 * D_MODEL:] * y_mem)
        x = x + merged @ w_out[l]
        x = x + 0.5 * swiglu(rmsnorm(x, ffn2_norm[l]), ffn2_w_gate[l], ffn2_w_up[l], ffn2_w_down[l])
    return rmsnorm(x, final_norm)
```

```cpp
#include <hip/hip_runtime.h>
#include <hip/hip_cooperative_groups.h>
#include <cstdio>
namespace cg = cooperative_groups;

#define LAS __attribute__((address_space(3)))
typedef unsigned short bf16_t;
typedef short bf16x8 __attribute__((ext_vector_type(8)));
typedef float f32x4 __attribute__((ext_vector_type(4)));
typedef unsigned u32x4 __attribute__((ext_vector_type(4)));
typedef unsigned u32x2 __attribute__((ext_vector_type(2)));

constexpr int S = 16384, D = 2048, FF = 5632, NMEM = 256;
constexpr int INC = 12800;
#define DBG_ATT 1
#ifndef PROBE_PH
#define PROBE_PH 99
#endif
constexpr float EPS = 1e-6f;
constexpr float LOG2E = 1.4426950408889634f;
constexpr size_t MiB = 1ull << 20;
constexpr size_t WS_WA   = 0;
constexpr size_t WS_WIN  = WS_WA + 66 * MiB;
constexpr size_t WS_WKV  = WS_WIN + 50 * MiB;
constexpr size_t WS_WUPP = WS_WKV + 8 * MiB;
constexpr size_t WS_WUPA = WS_WUPP + 4 * MiB;
constexpr size_t WS_WUPM = WS_WUPA + 2 * MiB;
constexpr size_t WS_WOUT = WS_WUPM + 4 * MiB;
constexpr size_t WS_WPOOL = WS_WOUT + 8 * MiB;
constexpr size_t WS_R2   = WS_WPOOL + 1 * MiB;
constexpr size_t WS_R3   = WS_R2 + 208 * MiB;
constexpr size_t WS_R5   = WS_R3 + 64 * MiB;
constexpr size_t WS_COS  = WS_R5 + 96 * MiB;
constexpr size_t WS_SIN  = WS_COS + 4 * MiB;
constexpr size_t WS_MEMN = WS_SIN + 4 * MiB;
constexpr size_t WS_KVMK = WS_MEMN + 1 * MiB;
constexpr size_t WS_VMT  = WS_KVMK + MiB / 2;
constexpr size_t WS_LSE  = WS_VMT + MiB / 2;
constexpr size_t WS_BAR  = WS_LSE + 1 * MiB;
constexpr size_t WS_WG8  = WS_BAR + 1 * MiB;
constexpr size_t WS_W8B  = WS_WG8 + 12 * MiB;
constexpr size_t WS_END  = WS_W8B + 11 * MiB;

typedef float f32x2 __attribute__((ext_vector_type(2)));
typedef __bf16 bf16x2v __attribute__((ext_vector_type(2)));
__device__ __forceinline__ unsigned cvt_pk_bf16(float lo, float hi) { const f32x2 v = {lo, hi}; const bf16x2v b = __builtin_convertvector(v, bf16x2v); return __builtin_bit_cast(unsigned, b); }
__device__ __forceinline__ float bf_lo(unsigned w) { return __uint_as_float(w << 16); }
__device__ __forceinline__ float bf_hi(unsigned w) { return __uint_as_float(w & 0xffff0000u); }
__device__ __forceinline__ unsigned pk_fp8x4(f32x4 v) { unsigned w = __builtin_amdgcn_cvt_pk_fp8_f32(v[0], v[1], 0, false); return __builtin_amdgcn_cvt_pk_fp8_f32(v[2], v[3], w, true); }
__device__ __forceinline__ int lane_id() { return (int)__builtin_amdgcn_mbcnt_hi(~0u, __builtin_amdgcn_mbcnt_lo(~0u, 0u)); }
__device__ __forceinline__ float fast_exp2(float x) { return __builtin_amdgcn_exp2f(x); }
__device__ __forceinline__ float fast_rcp(float x) { return __builtin_amdgcn_rcpf(x); }

constexpr int BM = 256, BK = 64, HALF = 128, HTB = HALF * BK * 2, STAGE_BYTES = 8 * HTB, NXCD = 8, WGM = 4;
__device__ __forceinline__ int lds_byte(int r, int c) { const int st = (r >> 4) * 2 + (c >> 5), rr = r & 15, cc = c & 31, ob = rr * 64 + cc * 2; return st * 1024 + (ob ^ (((ob >> 9) & 1) << 5)); }
__device__ __forceinline__ void stage_rc(int b, int& R, int& C) { const int st = b / 1024, sb = b % 1024, swz = sb ^ (((sb >> 9) & 1) << 5); R = (st >> 1) * 16 + swz / 64; C = (st & 1) * 32 + (swz % 64) / 2; }
__device__ __forceinline__ int perm32(int rho) { const int n = rho >> 4, i = rho & 15; return 8 * (i >> 2) + 4 * n + (i & 3); }
__host__ __device__ __forceinline__ int permb(int c) { return (c & ~31) + 16 * ((c >> 2) & 1) + 4 * ((c & 31) >> 3) + (c & 3); }

struct Unit { int pm, pn; };
struct Gemm { const bf16_t* A; const bf16_t* Bt; int lda, ldb, M, N, K; };
struct StaticOrder {
    int nM, nN, nwg, G, c;
    __device__ void init(int M, int N, int G_, int c_) { nM = M / BM; nN = N / BM; nwg = nM * nN; G = G_; c = c_; }
    __device__ bool next(int i, Unit& u) const {
        const long L = (long)i * G + c; if (L >= nwg) return false;
        int wgid = (int)L; { const int q = nwg / NXCD, r = nwg % NXCD, xcd = wgid % NXCD, off = wgid / NXCD; wgid = (xcd < r ? xcd * (q + 1) : r * (q + 1) + (xcd - r) * q) + off; }
        const int nig = WGM * nN, gid = wgid / nig, fm = gid * WGM, gsz = (nM - fm) < WGM ? (nM - fm) : WGM;
        u.pm = fm + ((wgid % nig) % gsz); u.pn = (wgid % nig) / gsz; return true;
    }
};

template <int BP> __device__ __forceinline__ int bperm_row(int R) {
    if (BP == 0) return R;
    const int v = (R & ~31) + perm32(R & 31);
    if (BP == 1) return v;
    constexpr int per = 256 / (BP > 1 ? BP : 2);
    const int r = v / per, l = v % per;
    return l * BP + r;
}

typedef int i32x4 __attribute__((ext_vector_type(4)));
typedef int i32x8 __attribute__((ext_vector_type(8)));
__device__ __forceinline__ i32x8 cat8(bf16x8 a, bf16x8 b) { return __builtin_shufflevector(__builtin_bit_cast(i32x4, a), __builtin_bit_cast(i32x4, b), 0, 1, 2, 3, 4, 5, 6, 7); }
__device__ __forceinline__ void mfma_fp8_inplace(f32x4& c, const i32x8 a, const i32x8 b) { asm volatile("v_mfma_f32_16x16x128_f8f6f4 %0, %1, %2, %0" : "+v"(c) : "v"(a), "v"(b)); }
template <class Epi, int BP, bool FP8 = false>
__device__ __forceinline__ void gemm_phase(LAS unsigned char* lds, const Gemm g, const StaticOrder& S_, const Epi& E, const int wid) {
    const int lane = lane_id(), tid = wid * 64 + lane, wr = wid >> 2, wc = wid & 3, fr = lane & 15, fq = lane >> 4;
    int K_ = g.K; asm volatile("" : "+s"(K_));
    const int K = K_, nt = K / BK;
    unsigned voffA, voffB;
    { int R, C; stage_rc(tid * 16, R, C); voffA = (unsigned)(R * g.lda + C) * 2u; voffB = (unsigned)(bperm_row<BP>(R) * g.ldb + C) * 2u; }
    const size_t d64A = (size_t)64 * g.lda * 2, d64B = (size_t)(BP <= 1 ? 64 : BP / 4) * g.ldb * 2;
    const size_t kstep = (size_t)(BK * 2);
    const size_t hstepA = (size_t)HALF * g.lda * 2;
    const size_t hstepB = (size_t)(BP <= 1 ? HALF : BP / 2) * g.ldb * 2;
    const size_t tstepA = (size_t)BM * g.lda * 2, tstepB = (size_t)BM * g.ldb * 2;
    const unsigned ldsw = (unsigned)wid * 1024u;
    const int aoff = lds_byte(wr * 64 + fr, FP8 ? fq * 16 : fq * 8), boff = lds_byte(wc * 32 + fr, FP8 ? fq * 16 : fq * 8);
    constexpr int KOFF = FP8 ? 16 : 1024;
#define PG8_SA(b, h) (((b) * 2 + (h)) * HTB)
#define PG8_SB(b, h) ((4 + (b) * 2 + (h)) * HTB)
#define PG8_STAGE(bufoff, gbase, voff) do { _Pragma("unroll") for (int _i = 0; _i < 2; ++_i) \
        __builtin_amdgcn_global_load_lds((const unsigned*)((const char*)(gbase) + (size_t)_i * (&(voff) == &voffA ? d64A : d64B) + (voff)), (LAS unsigned*)(lds + (bufoff) + ldsw + _i * 8192), 16, 0, 0); } while (0)
#define PG8_LDA(dst, b, h) do { if constexpr (FP8) { _Pragma("unroll") for (int m = 0; m < 4; ++m) dst##8[m] = cat8(*(const LAS bf16x8*)(lds + PG8_SA(b, h) + aoff + m * 2048), *(const LAS bf16x8*)(lds + PG8_SA(b, h) + aoff + m * 2048 + 16)); } \
        else { _Pragma("unroll") for (int m = 0; m < 4; ++m) _Pragma("unroll") for (int k = 0; k < 2; ++k) dst[m][k] = *(const LAS bf16x8*)(lds + PG8_SA(b, h) + aoff + m * 2048 + k * KOFF); } } while (0)
#define PG8_LDB(dst, b, h) do { if constexpr (FP8) { _Pragma("unroll") for (int n = 0; n < 2; ++n) dst##8[n] = cat8(*(const LAS bf16x8*)(lds + PG8_SB(b, h) + boff + n * 2048), *(const LAS bf16x8*)(lds + PG8_SB(b, h) + boff + n * 2048 + 16)); } \
        else { _Pragma("unroll") for (int n = 0; n < 2; ++n) _Pragma("unroll") for (int k = 0; k < 2; ++k) dst[n][k] = *(const LAS bf16x8*)(lds + PG8_SB(b, h) + boff + n * 2048 + k * KOFF); } } while (0)
#define PG8_MMA(ai, bj, At, Bt) do { __builtin_amdgcn_s_setprio(1); \
        if constexpr (FP8) { _Pragma("unroll") for (int m = 0; m < 4; ++m) _Pragma("unroll") for (int n = 0; n < 2; ++n) \
            mfma_fp8_inplace(acc[ai][bj][m][n], Bt##8[n], At##8[m]); } \
        else { _Pragma("unroll") for (int m = 0; m < 4; ++m) _Pragma("unroll") for (int n = 0; n < 2; ++n) _Pragma("unroll") for (int k = 0; k < 2; ++k) \
            acc[ai][bj][m][n] = __builtin_amdgcn_mfma_f32_16x16x32_bf16(Bt[n][k], At[m][k], acc[ai][bj][m][n], 0, 0, 0); } \
        __builtin_amdgcn_s_setprio(0); } while (0)
#define PG8_WAIT_V(n) asm volatile("s_waitcnt vmcnt(" #n ")" ::: "memory")
#define PG8_WAIT_L(n) asm volatile("s_waitcnt lgkmcnt(" #n ")" ::: "memory")
#define PG8_BAR __builtin_amdgcn_s_barrier()
#define PG8_SCHED __builtin_amdgcn_sched_barrier(0)
    Unit cur, nxt; int ui = 0;
    if (!S_.next(0, cur)) return;
    f32x4 acc[2][2][4][2];
#pragma unroll
    for (int a = 0; a < 2; ++a)
#pragma unroll
        for (int b = 0; b < 2; ++b)
#pragma unroll
            for (int m = 0; m < 4; ++m)
#pragma unroll
                for (int n = 0; n < 2; ++n) acc[a][b][m][n] = (f32x4){0.f, 0.f, 0.f, 0.f};
    bf16x8 At[4][2], B0[2][2], B1[2][2]; i32x8 At8[4], B08[2], B18[2];
    const char* cA = (const char*)g.A + (size_t)cur.pm * tstepA; const char* cB = (const char*)g.Bt + (size_t)cur.pn * tstepB;
    PG8_STAGE(PG8_SB(0, 0), cB, voffB); PG8_STAGE(PG8_SA(0, 0), cA, voffA); PG8_STAGE(PG8_SB(0, 1), cB + hstepB, voffB); PG8_STAGE(PG8_SA(0, 1), cA + hstepA, voffA);
    if (wr == 1) PG8_BAR;
    PG8_WAIT_V(4); PG8_BAR;
    PG8_STAGE(PG8_SB(1, 0), cB + kstep, voffB); PG8_STAGE(PG8_SA(1, 0), cA + kstep, voffA); PG8_STAGE(PG8_SB(1, 1), cB + hstepB + kstep, voffB);
    PG8_WAIT_V(6); PG8_BAR;
    for (;;) {
        const bool has_next = S_.next(ui + 1, nxt);
        const char* nA = has_next ? (const char*)g.A + (size_t)nxt.pm * tstepA : cA; const char* nB = has_next ? (const char*)g.Bt + (size_t)nxt.pn * tstepB : cB;
        for (int t = 0; t < nt; t += 2) {
            const bool last = (t == nt - 2);
            const char* a1 = cA + (size_t)(t + 1) * kstep;
            const char* a2 = last ? nA : cA + (size_t)(t + 2) * kstep; const char* b2 = last ? nB : cB + (size_t)(t + 2) * kstep;
            const char* a3 = a2 + kstep; const char* b3 = b2 + kstep;
            PG8_LDB(B0, 0, 0); PG8_SCHED; PG8_LDA(At, 0, 0); PG8_STAGE(PG8_SA(1, 1), a1 + hstepA, voffA);
            PG8_WAIT_L(8); PG8_BAR; PG8_WAIT_L(0); PG8_MMA(0, 0, At, B0); PG8_BAR; PG8_SCHED;
            PG8_LDB(B1, 0, 1); PG8_STAGE(PG8_SB(0, 0), b2, voffB);
            PG8_BAR; PG8_WAIT_L(0); PG8_MMA(0, 1, At, B1); PG8_BAR;
            PG8_LDA(At, 0, 1); PG8_STAGE(PG8_SA(0, 0), a2, voffA);
            PG8_BAR; PG8_WAIT_L(0); PG8_MMA(1, 0, At, B0); PG8_BAR; PG8_SCHED;
            PG8_STAGE(PG8_SB(0, 1), b2 + hstepB, voffB);
            PG8_WAIT_V(6); PG8_BAR; PG8_MMA(1, 1, At, B1); PG8_BAR;
            PG8_LDB(B0, 1, 0); PG8_SCHED; PG8_LDA(At, 1, 0); PG8_STAGE(PG8_SA(0, 1), a2 + hstepA, voffA);
            PG8_WAIT_L(8); PG8_BAR; PG8_WAIT_L(0); PG8_MMA(0, 0, At, B0); PG8_BAR; PG8_SCHED;
            PG8_LDB(B1, 1, 1); PG8_STAGE(PG8_SB(1, 0), b3, voffB);
            PG8_BAR; PG8_WAIT_L(0); PG8_MMA(0, 1, At, B1); PG8_BAR;
            PG8_LDA(At, 1, 1); PG8_STAGE(PG8_SA(1, 0), a3, voffA);
            PG8_BAR; PG8_WAIT_L(0); PG8_MMA(1, 0, At, B0); PG8_BAR; PG8_SCHED;
            PG8_STAGE(PG8_SB(1, 1), b3 + hstepB, voffB);
            PG8_WAIT_V(6); PG8_BAR; PG8_MMA(1, 1, At, B1); PG8_BAR;
        }
        if constexpr (FP8) asm volatile("s_nop 15\n\ts_nop 15" ::: "memory");
        { const int ln_ = __builtin_amdgcn_mbcnt_hi(~0u, __builtin_amdgcn_mbcnt_lo(~0u, 0u)); E(acc, cur, wr, wc, ln_ & 15, ln_ >> 4); }
        if (!has_next) break;
#pragma unroll
        for (int a = 0; a < 2; ++a)
#pragma unroll
            for (int b = 0; b < 2; ++b)
#pragma unroll
                for (int m = 0; m < 4; ++m)
#pragma unroll
                    for (int n = 0; n < 2; ++n) acc[a][b][m][n] = (f32x4){0.f, 0.f, 0.f, 0.f};
        cur = nxt; cA = nA; cB = nB; ++ui;
    }
    PG8_WAIT_V(0);
    if (wr == 0) PG8_BAR;
    PG8_BAR;
#undef PG8_SA
#undef PG8_SB
#undef PG8_STAGE
#undef PG8_LDA
#undef PG8_LDB
#undef PG8_MMA
#undef PG8_WAIT_V
#undef PG8_WAIT_L
#undef PG8_BAR
#undef PG8_SCHED
}

typedef f32x4 AccT[2][2][4][2];
__device__ __forceinline__ u32x4 pack8(f32x4 a, f32x4 b) { u32x4 w; w.x = cvt_pk_bf16(a[0], a[1]); w.y = cvt_pk_bf16(a[2], a[3]); w.z = cvt_pk_bf16(b[0], b[1]); w.w = cvt_pk_bf16(b[2], b[3]); return w; }
__device__ __forceinline__ u32x2 pack4(f32x4 a) { u32x2 w; w.x = cvt_pk_bf16(a[0], a[1]); w.y = cvt_pk_bf16(a[2], a[3]); return w; }

struct EpiGU { bf16_t* act;
    __device__ __forceinline__ void operator()(const AccT& acc, const Unit& u, int wr, int wc, int fr, int fq) const {
        const int row0 = u.pm * BM + wr * 64 + fr, col0 = u.pn * 128 + wc * 32 + 8 * fq;
#pragma unroll
        for (int ai = 0; ai < 2; ++ai)
#pragma unroll
            for (int m = 0; m < 4; ++m) { f32x4 v[2];
#pragma unroll
                for (int n = 0; n < 2; ++n) { const f32x4 gt = acc[ai][0][m][n], up = acc[ai][1][m][n];
#pragma unroll
                    for (int j = 0; j < 4; ++j) v[n][j] = gt[j] * fast_rcp(1.0f + fast_exp2(-gt[j] * LOG2E)) * up[j]; }
                *(u32x4*)(act + (size_t)(row0 + ai * HALF + m * 16) * FF + col0) = pack8(v[0], v[1]); }
    }
};
struct EpiRes { const float* xin; float* xout; float alpha;
    __device__ __forceinline__ void operator()(const AccT& acc, const Unit& u, int wr, int wc, int fr, int fq) const {
        const int row0 = u.pm * BM + wr * 64 + fr, col0 = u.pn * BM + wc * 32 + 4 * fq;
#pragma unroll
        for (int ai = 0; ai < 2; ++ai)
#pragma unroll
            for (int m = 0; m < 4; ++m) { const size_t off = (size_t)(row0 + ai * HALF + m * 16) * D + col0;
#pragma unroll
                for (int bj = 0; bj < 2; ++bj)
#pragma unroll
                    for (int n = 0; n < 2; ++n) { const f32x4 b = *(const f32x4*)(xin + off + bj * HALF + n * 16); *(f32x4*)(xout + off + bj * HALF + n * 16) = b + alpha * acc[ai][bj][m][n]; }
                asm volatile("" ::: "memory"); }
    }
};
template <bool XF32> struct EpiResB { const void* xin; bf16_t* xout; float alpha; int pad_;
    __device__ __forceinline__ void operator()(const AccT& acc, const Unit& u, int wr, int wc, int fr, int fq) const {
        const int row0 = u.pm * BM + wr * 64 + fr, col0 = u.pn * BM + wc * 32 + 8 * fq;
        const float al = alpha; const float* const xf = (const float*)xin; const bf16_t* const xb = (const bf16_t*)xin; bf16_t* const xo = xout;
#pragma unroll
        for (int ai = 0; ai < 2; ++ai)
#pragma unroll
            for (int m = 0; m < 4; ++m) { const size_t off = (size_t)(row0 + ai * HALF + m * 16) * D + col0;
#pragma unroll
                for (int bj = 0; bj < 2; ++bj) { f32x4 b0, b1;
                    if (XF32) { b0 = *(const f32x4*)(xf + off + bj * HALF); b1 = *(const f32x4*)(xf + off + bj * HALF + 4); }
                    else { const u32x4 w = *(const u32x4*)(xb + off + bj * HALF); b0 = (f32x4){bf_lo(w.x), bf_hi(w.x), bf_lo(w.y), bf_hi(w.y)}; b1 = (f32x4){bf_lo(w.z), bf_hi(w.z), bf_lo(w.w), bf_hi(w.w)}; }
                    *(u32x4*)(xo + off + bj * HALF) = pack8(b0 + al * acc[ai][bj][m][0], b1 + al * acc[ai][bj][m][1]); } }
    }
};
__device__ __forceinline__ void epi_plain(const AccT& acc, bf16_t* O, int ldc, int rowt, int colt, float scale, int wr, int wc, int fr, int fq) {
    const int row0 = rowt + wr * 64 + fr, col0 = colt + wc * 32 + 8 * fq;
#pragma unroll
    for (int ai = 0; ai < 2; ++ai)
#pragma unroll
        for (int m = 0; m < 4; ++m) { bf16_t* rowp = O + (size_t)(row0 + ai * HALF + m * 16) * ldc + col0;
#pragma unroll
            for (int bj = 0; bj < 2; ++bj) *(u32x4*)(rowp + bj * HALF) = pack8(acc[ai][bj][m][0] * scale, acc[ai][bj][m][1] * scale); }
}
struct EpiProj { bf16_t *u, *q, *k, *qm; const float* cs; const float* sn; float qscale, qmscale, kscale; int pn_off;
    __device__ __forceinline__ void operator()(const AccT& acc, const Unit& un, int wr, int wc, int fr, int fq) const {
        const int pn = un.pn + pn_off;
        if (pn < 4) { epi_plain(acc, u, 1024, un.pm * BM, pn * BM, 1.0f, wr, wc, fr, fq); return; }
        if (pn >= 16) { epi_plain(acc, qm, 1024, un.pm * BM, (pn - 16) * BM, qmscale, wr, wc, fr, fq); return; }
        const bool isq = pn < 10; bf16_t* base = isq ? q : k; const int colt = (pn - (isq ? 4 : 10)) * BM; const float sc = isq ? qscale : kscale;
        const int row0 = un.pm * BM + wr * 64 + fr, d0 = 16 * wc + 4 * fq;
#pragma unroll
        for (int ai = 0; ai < 2; ++ai)
#pragma unroll
            for (int m = 0; m < 4; ++m) { const int row = row0 + ai * HALF + m * 16;
                const f32x4 c = *(const f32x4*)(cs + (size_t)row * 64 + d0) * sc, s = *(const f32x4*)(sn + (size_t)row * 64 + d0) * sc;
#pragma unroll
                for (int bj = 0; bj < 2; ++bj) { const f32x4 t1 = acc[ai][bj][m][0], t2 = acc[ai][bj][m][1];
                    bf16_t* p = base + (size_t)row * 1536 + colt + bj * HALF + d0;
                    *(u32x2*)p = pack4(t1 * c - t2 * s); *(u32x2*)(p + 64) = pack4(t2 * c + t1 * s); } }
    }
};
template <int DIL> struct EpiVt { bf16_t* vt; float sc; int pad_;
    __device__ __forceinline__ void operator()(const AccT& acc, const Unit& u, int wr, int wc, int fr, int fq) const {
        constexpr int per = 256 / DIL, L8 = S / DIL / 8;
#pragma unroll
        for (int bj = 0; bj < 2; ++bj) { const int v0 = bj * HALF + wc * 32 + 8 * fq, r = v0 / per, l = per * u.pn + (v0 % per);
#pragma unroll
            for (int ai = 0; ai < 2; ++ai)
#pragma unroll
                for (int m = 0; m < 4; ++m) { const int grow = u.pm * BM + ai * HALF + wr * 64 + m * 16 + fr, hg = grow >> 7, dim = grow & 127;
                    *(u32x4*)(vt + ((((size_t)hg * DIL + r) * L8 + (l >> 3)) * 128 + dim) * 8) = pack8(acc[ai][bj][m][0] * sc, acc[ai][bj][m][1] * sc); } }
    }
};
struct EpiGate { bf16_t* gates; const float* bias; float ascale; int pad_;
    __device__ __forceinline__ void operator()(const AccT& acc, const Unit& u, int wr, int wc, int fr, int fq) const {
        const int row0 = u.pm * BM + wr * 64 + fr, col0 = u.pn * BM + wc * 32 + 8 * fq;
#pragma unroll
        for (int bj = 0; bj < 2; ++bj) { const f32x4 b0 = *(const f32x4*)(bias + col0 + bj * HALF), b1 = *(const f32x4*)(bias + col0 + bj * HALF + 4);
#pragma unroll
            for (int ai = 0; ai < 2; ++ai)
#pragma unroll
                for (int m = 0; m < 4; ++m) { f32x4 v0 = acc[ai][bj][m][0] * ascale + b0, v1 = acc[ai][bj][m][1] * ascale + b1;
#pragma unroll
                    for (int j = 0; j < 4; ++j) { v0[j] = fast_rcp(1.0f + fast_exp2(-v0[j] * LOG2E)); v1[j] = fast_rcp(1.0f + fast_exp2(-v1[j] * LOG2E)); }
                    *(u32x4*)(gates + (size_t)(row0 + ai * HALF + m * 16) * (3 * D) + col0 + bj * HALF) = pack8(v0, v1); } }
    }
};
struct EpiPm { bf16_t* pm; const float* scale; int g;
    __device__ __forceinline__ void operator()(const AccT& acc, const Unit& u, int wr, int wc, int fr, int fq) const {
        const int row0 = u.pm * BM + wr * 64 + fr, col0 = g * 256 + wc * 32 + 8 * fq;
#pragma unroll
        for (int bj = 0; bj < 2; ++bj) { const f32x4 s0 = *(const f32x4*)(scale + col0 + bj * HALF), s1 = *(const f32x4*)(scale + col0 + bj * HALF + 4);
#pragma unroll
            for (int ai = 0; ai < 2; ++ai)
#pragma unroll
                for (int m = 0; m < 4; ++m)
                    *(u32x4*)(pm + (size_t)(row0 + ai * HALF + m * 16) * 1024 + col0 + bj * HALF) = pack8(acc[ai][bj][m][0] * s0, acc[ai][bj][m][1] * s1); }
    }
};
struct EpiUp { bf16_t* merged; const bf16_t* gates; int b; float sc;
    __device__ __forceinline__ void operator()(const AccT& acc, const Unit& u, int wr, int wc, int fr, int fq) const {
        const int row0 = u.pm * BM + wr * 64 + fr, col0 = u.pn * BM + wc * 32 + 8 * fq;
#pragma unroll
        for (int ai = 0; ai < 2; ++ai)
#pragma unroll
            for (int m = 0; m < 4; ++m) { const size_t row = (size_t)(row0 + ai * HALF + m * 16);
#pragma unroll
                for (int bj = 0; bj < 2; ++bj) { const u32x4 gw = *(const u32x4*)(gates + row * (3 * D) + b * D + col0 + bj * HALF);
                    bf16_t* mp = merged + row * D + col0 + bj * HALF;
                    f32x4 p0 = (f32x4){0.f, 0.f, 0.f, 0.f}, p1 = p0;
                    if (b > 0) { const u32x4 pw = *(const u32x4*)mp; p0 = (f32x4){bf_lo(pw.x), bf_hi(pw.x), bf_lo(pw.y), bf_hi(pw.y)}; p1 = (f32x4){bf_lo(pw.z), bf_hi(pw.z), bf_lo(pw.w), bf_hi(pw.w)}; }
                    const f32x4 g0 = (f32x4){bf_lo(gw.x), bf_hi(gw.x), bf_lo(gw.y), bf_hi(gw.y)}, g1 = (f32x4){bf_lo(gw.z), bf_hi(gw.z), bf_lo(gw.w), bf_hi(gw.w)};
                    *(u32x4*)mp = pack8(p0 + g0 * (acc[ai][bj][m][0] * sc), p1 + g1 * (acc[ai][bj][m][1] * sc)); } }
    }
};
struct EpiKvmK { bf16_t* kk;
    __device__ __forceinline__ void operator()(const AccT& acc, const Unit& u, int wr, int wc, int fr, int fq) const { epi_plain(acc, kk, 1024, u.pm * BM, u.pn * BM, 1.0f, wr, wc, fr, fq); }
};
struct EpiKvmVt { bf16_t* vmt;
    __device__ __forceinline__ void operator()(const AccT& acc, const Unit& u, int wr, int wc, int fr, int fq) const {
#pragma unroll
        for (int bj = 0; bj < 2; ++bj) { const int tb = (bj * HALF + wc * 32 + 8 * fq) >> 3;
#pragma unroll
            for (int ai = 0; ai < 2; ++ai)
#pragma unroll
                for (int m = 0; m < 4; ++m) { const int grow = u.pm * BM + ai * HALF + wr * 64 + m * 16 + fr, hm = grow >> 8, dim = grow & 255;
                    *(u32x4*)(vmt + (((size_t)hm * 32 + tb) * 256 + dim) * 8) = pack8(acc[ai][bj][m][0], acc[ai][bj][m][1]); } }
    }
};

template <bool OUT_BF16>
__device__ __forceinline__ void rmsnorm_rows(const float* x, const float* g, void* out, int nrows, int wave0, int nwaves, int lane) {
    for (int r = wave0; r < nrows; r += 2 * nwaves) {
        const int r2 = r + nwaves; const bool two = r2 < nrows;
        const float* xr = x + (size_t)r * D; const float* xq = x + (size_t)(two ? r2 : r) * D; f32x4 v[8], w[8]; float ss = 0.f, st = 0.f;
#pragma unroll
        for (int c = 0; c < 8; ++c) v[c] = *(const f32x4*)(xr + (c * 64 + lane) * 4);
#pragma unroll
        for (int c = 0; c < 8; ++c) w[c] = *(const f32x4*)(xq + (c * 64 + lane) * 4);
#pragma unroll
        for (int c = 0; c < 8; ++c) { ss += v[c][0] * v[c][0] + v[c][1] * v[c][1] + v[c][2] * v[c][2] + v[c][3] * v[c][3]; st += w[c][0] * w[c][0] + w[c][1] * w[c][1] + w[c][2] * w[c][2] + w[c][3] * w[c][3]; }
#pragma unroll
        for (int o = 32; o >= 1; o >>= 1) { ss += __shfl_xor(ss, o); st += __shfl_xor(st, o); }
        const float rs = 1.0f / sqrtf(ss * (1.0f / D) + EPS), rt = 1.0f / sqrtf(st * (1.0f / D) + EPS);
#pragma unroll
        for (int c = 0; c < 8; ++c) { const f32x4 gg = *(const f32x4*)(g + (c * 64 + lane) * 4); const f32x4 y = v[c] * rs * gg, z = w[c] * rt * gg;
            if (OUT_BF16) { *(u32x2*)((bf16_t*)out + (size_t)r * D + (c * 64 + lane) * 4) = pack4(y); if (two) *(u32x2*)((bf16_t*)out + (size_t)r2 * D + (c * 64 + lane) * 4) = pack4(z); }
            else { *(f32x4*)((float*)out + (size_t)r * D + (c * 64 + lane) * 4) = y; if (two) *(f32x4*)((float*)out + (size_t)r2 * D + (c * 64 + lane) * 4) = z; } }
    }
}

template <bool OUT_BF16>
__device__ __forceinline__ void rmsnorm_rows_b(const bf16_t* x, const float* g, void* out, int nrows, int wave0, int nwaves, int lane, unsigned char* out8 = nullptr) {
    for (int r = wave0; r < nrows; r += 2 * nwaves) {
        const int r2 = r + nwaves; const bool two = r2 < nrows;
        const bf16_t* xr = x + (size_t)r * D; const bf16_t* xq = x + (size_t)(two ? r2 : r) * D; u32x4 v[4], w[4]; float ss = 0.f, st = 0.f;
#pragma unroll
        for (int c = 0; c < 4; ++c) v[c] = *(const u32x4*)(xr + (c * 64 + lane) * 8);
#pragma unroll
        for (int c = 0; c < 4; ++c) w[c] = *(const u32x4*)(xq + (c * 64 + lane) * 8);
        f32x4 a[4][2], b[4][2];
#pragma unroll
        for (int c = 0; c < 4; ++c) { a[c][0] = (f32x4){bf_lo(v[c].x), bf_hi(v[c].x), bf_lo(v[c].y), bf_hi(v[c].y)}; a[c][1] = (f32x4){bf_lo(v[c].z), bf_hi(v[c].z), bf_lo(v[c].w), bf_hi(v[c].w)};
            b[c][0] = (f32x4){bf_lo(w[c].x), bf_hi(w[c].x), bf_lo(w[c].y), bf_hi(w[c].y)}; b[c][1] = (f32x4){bf_lo(w[c].z), bf_hi(w[c].z), bf_lo(w[c].w), bf_hi(w[c].w)};
#pragma unroll
            for (int k = 0; k < 2; ++k) { ss += a[c][k][0] * a[c][k][0] + a[c][k][1] * a[c][k][1] + a[c][k][2] * a[c][k][2] + a[c][k][3] * a[c][k][3];
                st += b[c][k][0] * b[c][k][0] + b[c][k][1] * b[c][k][1] + b[c][k][2] * b[c][k][2] + b[c][k][3] * b[c][k][3]; } }
#pragma unroll
        for (int o = 32; o >= 1; o >>= 1) { ss += __shfl_xor(ss, o); st += __shfl_xor(st, o); }
        const float rs = 1.0f / sqrtf(ss * (1.0f / D) + EPS), rt = 1.0f / sqrtf(st * (1.0f / D) + EPS);
#pragma unroll
        for (int c = 0; c < 4; ++c) { const int e0 = (c * 64 + lane) * 8; const f32x4 g0 = *(const f32x4*)(g + e0), g1 = *(const f32x4*)(g + e0 + 4);
            const f32x4 y0 = a[c][0] * rs * g0, y1 = a[c][1] * rs * g1, z0 = b[c][0] * rt * g0, z1 = b[c][1] * rt * g1;
            if (OUT_BF16) { *(u32x4*)((bf16_t*)out + (size_t)r * D + e0) = pack8(y0, y1); if (two) *(u32x4*)((bf16_t*)out + (size_t)r2 * D + e0) = pack8(z0, z1);
                if (out8) { u32x2 q; q.x = pk_fp8x4(y0); q.y = pk_fp8x4(y1); *(u32x2*)(out8 + (size_t)r * D + e0) = q; if (two) { u32x2 q2; q2.x = pk_fp8x4(z0); q2.y = pk_fp8x4(z1); *(u32x2*)(out8 + (size_t)r2 * D + e0) = q2; } } }
            else { float* o1 = (float*)out + (size_t)r * D + e0; *(f32x4*)o1 = y0; *(f32x4*)(o1 + 4) = y1;
                   if (two) { float* o2 = (float*)out + (size_t)r2 * D + e0; *(f32x4*)o2 = z0; *(f32x4*)(o2 + 4) = z1; } } }
    }
}

__device__ __forceinline__ int rope_slot(int d) { const int n = d >> 6, dd = d & 63; return 32 * (dd >> 4) + 16 * n + (dd & 15); }
__device__ __forceinline__ int slot_of(int mode, int c) {
    switch (mode) {
    case 0: return c;
    case 1: return permb(c);
    case 2: if (c < 1024) return permb(c);
            if (c < 2560) { const int x = c - 1024; return 1024 + (x & ~127) + rope_slot(x & 127); }
            if (c < 4096) { const int x = c - 2560; return 2560 + (x & ~127) + rope_slot(x & 127); }
            if (c < 5632) return 5120 + (c - 4096);
            if (c < 6656) return 4096 + permb(c - 5632);
            return 6656 + permb(c - 6656);
    case 3: return 256 * (c >> 7) + permb(c & 127);
    case 4: return 256 * (c >> 7) + 128 + permb(c & 127);
    default: return c < 1024 ? permb(c) : c;
    }
}
__device__ __forceinline__ void cvt_matrix(LAS unsigned char* lds, const float* src, int Ks, int Ns, bf16_t* dst, int mode, int& rot, int bid, int G, int tid, int wave, int lane) {
    const int nkt = Ks / 64, ntiles = nkt * (Ns / 256);
    int t = (bid + G - rot) % G; rot = (rot + ntiles) % G; if (t >= ntiles) return;
    float v[8][4];
    { const int kt = t % nkt, cn = t / nkt; const float* p = src + (size_t)(kt * 64 + wave * 8) * Ns + cn * 256 + lane;
#pragma unroll
      for (int i = 0; i < 8; ++i)
#pragma unroll
          for (int j = 0; j < 4; ++j) v[i][j] = p[(size_t)i * Ns + 64 * j]; }
    for (;;) {
        const int kt = t % nkt, cn = t / nkt;
#pragma unroll
        for (int j = 0; j < 4; ++j) { u32x4 w; w.x = cvt_pk_bf16(v[0][j], v[1][j]); w.y = cvt_pk_bf16(v[2][j], v[3][j]); w.z = cvt_pk_bf16(v[4][j], v[5][j]); w.w = cvt_pk_bf16(v[6][j], v[7][j]);
            *(LAS u32x4*)(lds + (lane + 64 * j) * 144 + wave * 16) = w; }
        const int tn = t + G;
        if (tn < ntiles) { const int kt2 = tn % nkt, cn2 = tn / nkt; const float* p = src + (size_t)(kt2 * 64 + wave * 8) * Ns + cn2 * 256 + lane;
#pragma unroll
            for (int i = 0; i < 8; ++i)
#pragma unroll
                for (int j = 0; j < 4; ++j) v[i][j] = p[(size_t)i * Ns + 64 * j]; }
        __syncthreads();
#pragma unroll
        for (int p_ = 0; p_ < 4; ++p_) { const int n = p_ * 64 + (tid >> 3), ch = tid & 7;
            const u32x4 w = *(const LAS u32x4*)(lds + n * 144 + ch * 16);
            *(u32x4*)(dst + (size_t)slot_of(mode, cn * 256 + n) * Ks + kt * 64 + ch * 8) = w; }
        __syncthreads();
        if (tn >= ntiles) break;
        t = tn;
    }
}

__device__ __forceinline__ void attn_tile(const bf16_t* q, const bf16_t* k, const bf16_t* vt, bf16_t* og, float* lse, int T, int lane) {
    const int fr = lane & 15, fq = lane >> 4;
    const int g = T >> 12, Tp = T & 4095, hg = Tp >> 10, Tpp = Tp & 1023;
    const int dsh = 2 * g, d = 1 << dsh, per = 1024 >> dsh, r = Tpp >> (10 - dsh), lb = Tpp & (per - 1), l0 = lb * 16, L = S >> dsh, L8 = L >> 3;
    const int head = g * 4 + hg, lstart = l0 - 64;
    bf16x8 qf[4];
    const int tok = (l0 + fr) * d + r;
    { const bf16_t* p = q + (size_t)tok * 1536 + head * 128 + fq * 8;
#pragma unroll
      for (int kk = 0; kk < 4; ++kk) qf[kk] = *(const bf16x8*)(p + kk * 32); }
    const bf16_t* kbase = k + head * 128 + fq * 8;
    bf16x8 kf[10][4];
#pragma unroll
    for (int kb = 0; kb < 10; ++kb) { int lk = lstart + 32 * (kb >> 1) + 8 * (fr >> 2) + 4 * (kb & 1) + (fr & 3); lk = lk < 0 ? 0 : (lk > L - 1 ? L - 1 : lk);
        const bf16_t* kp = kbase + (size_t)(lk * d + r) * 1536;
#pragma unroll
        for (int kk = 0; kk < 4; ++kk) kf[kb][kk] = *(const bf16x8*)(kp + kk * 32); }
    f32x4 st[10];
#pragma unroll
    for (int kb = 0; kb < 10; ++kb) { f32x4 a = (f32x4){0.f, 0.f, 0.f, 0.f};
#pragma unroll
        for (int kk = 0; kk < 4; ++kk) a = __builtin_amdgcn_mfma_f32_16x16x32_bf16(kf[kb][kk], qf[kk], a, 0, 0, 0);
        st[kb] = a; }
    const bf16_t* vg = vt + (size_t)g * (4 * (size_t)S * 128) + ((size_t)(hg * d + r) * L8) * 1024 + fr * 8;
    bf16x8 vf[5][8];
#pragma unroll
    for (int ks = 0; ks < 5; ++ks) { int tb = (lstart + 32 * ks + 8 * fq) >> 3; tb = tb < 0 ? 0 : (tb > L8 - 1 ? L8 - 1 : tb); const bf16_t* vp = vg + (size_t)tb * 1024;
#pragma unroll
        for (int db = 0; db < 8; ++db) vf[ks][db] = *(const bf16x8*)(vp + db * 128); }
    float m_ = -3.0e38f;
#pragma unroll
    for (int kb = 0; kb < 10; ++kb)
#pragma unroll
        for (int j = 0; j < 4; ++j) { const int kidx = 32 * (kb >> 1) + 8 * fq + 4 * (kb & 1) + j, lk = lstart + kidx, rel = kidx - 64 - fr;
            const bool ok = (lk >= 0) && (lk < L) && (rel >= -64) && (rel <= 64);
            const float s_ = ok ? st[kb][j] : -3.0e38f; st[kb][j] = s_; m_ = fmaxf(m_, s_); }
    m_ = fmaxf(m_, __shfl_xor(m_, 16)); m_ = fmaxf(m_, __shfl_xor(m_, 32));
    float su = 0.f;
#pragma unroll
    for (int kb = 0; kb < 10; ++kb)
#pragma unroll
        for (int j = 0; j < 4; ++j) { const float s_ = st[kb][j]; const float p_ = s_ > -1.0e38f ? fast_exp2(s_ - m_) : 0.f; st[kb][j] = p_; su += p_; }
    su += __shfl_xor(su, 16); su += __shfl_xor(su, 32);
    f32x4 o[8];
#pragma unroll
    for (int db = 0; db < 8; ++db) o[db] = (f32x4){0.f, 0.f, 0.f, 0.f};
#pragma unroll
    for (int ks = 0; ks < 5; ++ks) { const u32x4 w = pack8(st[2 * ks], st[2 * ks + 1]); const bf16x8 pf = __builtin_bit_cast(bf16x8, w);
#pragma unroll
        for (int db = 0; db < 8; ++db) o[db] = __builtin_amdgcn_mfma_f32_16x16x32_bf16(vf[ks][db], pf, o[db], 0, 0, 0); }
    const float inv = 1.0f / su;
    bf16_t* op = og + ((size_t)g * S + tok) * 512 + hg * 128 + 4 * fq;
#pragma unroll
    for (int db = 0; db < 8; ++db) *(u32x2*)(op + db * 16) = pack4(o[db] * inv);
    if (fq == 0) lse[((size_t)g * S + tok) * 4 + hg] = m_ + __log2f(su);
}

__device__ __forceinline__ void mem_unit(LAS unsigned char* lds, const bf16_t* qm, const bf16_t* kmk, const bf16_t* vmt, bf16_t* mo, unsigned char* mo8, int unit, int tid, int wave, int lane) {
    const int fr = lane & 15, fq = lane >> 4;
    const int hm = unit >> 7, tok = (unit & 127) * 128 + wave * 16 + fr;
#pragma unroll 4
    for (int i = 0; i < 16; ++i) { const int ch = tid + i * 512, row = ch >> 5, c = ch & 31;
        const u32x4 w = *(const u32x4*)(kmk + (size_t)row * 1024 + hm * 256 + c * 8);
        *(LAS u32x4*)(lds + row * 512 + ((c ^ ((row & 3) | (((row >> 3) & 3) << 2))) << 4)) = w; }
    bf16x8 qf[8];
    { const bf16_t* p = qm + (size_t)tok * 1024 + hm * 256 + fq * 8;
#pragma unroll
      for (int kk = 0; kk < 8; ++kk) qf[kk] = *(const bf16x8*)(p + kk * 32); }
    __syncthreads();
    bf16x8 pf[8];
    { const int krow0 = 8 * (fr >> 2) + (fr & 3), key4 = fr;
        f32x4 st[16];
#pragma unroll
        for (int kb = 0; kb < 16; ++kb) { const int row = 32 * (kb >> 1) + 4 * (kb & 1) + krow0; f32x4 a = (f32x4){0.f, 0.f, 0.f, 0.f};
#pragma unroll
            for (int kk = 0; kk < 8; ++kk) { const bf16x8 kf = *(const LAS bf16x8*)(lds + row * 512 + (((kk * 4 + fq) ^ key4) << 4));
                a = __builtin_amdgcn_mfma_f32_16x16x32_bf16(kf, qf[kk], a, 0, 0, 0); }
            st[kb] = a; }
        float m_ = -3.0e38f;
#pragma unroll
        for (int kb = 0; kb < 16; ++kb)
#pragma unroll
            for (int j = 0; j < 4; ++j) m_ = fmaxf(m_, st[kb][j]);
        m_ = fmaxf(m_, __shfl_xor(m_, 16)); m_ = fmaxf(m_, __shfl_xor(m_, 32));
        float su = 0.f;
#pragma unroll
        for (int kb = 0; kb < 16; ++kb)
#pragma unroll
            for (int j = 0; j < 4; ++j) { const float p_ = fast_exp2(st[kb][j] - m_); st[kb][j] = p_; su += p_; }
        su += __shfl_xor(su, 16); su += __shfl_xor(su, 32);
        const float inv = 1.0f / su;
#pragma unroll
        for (int ks = 0; ks < 8; ++ks) { const u32x4 w = pack8(st[2 * ks] * inv, st[2 * ks + 1] * inv); pf[ks] = __builtin_bit_cast(bf16x8, w); }
    }
    __syncthreads();
#pragma unroll 4
    for (int i = 0; i < 16; ++i) { const int ch = tid + i * 512;
        *(LAS u32x4*)(lds + ch * 16) = *(const u32x4*)(vmt + (size_t)hm * 65536 + (size_t)ch * 8); }
    __syncthreads();
    bf16_t* op = mo + (size_t)tok * 1024 + hm * 256 + 4 * fq;
#pragma unroll
    for (int db = 0; db < 16; ++db) { f32x4 a = (f32x4){0.f, 0.f, 0.f, 0.f};
#pragma unroll
        for (int ks = 0; ks < 8; ++ks) { const bf16x8 vf = *(const LAS bf16x8*)(lds + (((4 * ks + fq) * 256 + 16 * db + fr) << 4));
            a = __builtin_amdgcn_mfma_f32_16x16x32_bf16(vf, pf[ks], a, 0, 0, 0); }
        *(unsigned*)(mo8 + (size_t)tok * 1024 + hm * 256 + 4 * fq + db * 16) = pk_fp8x4(a * 16.0f); }
    __syncthreads();
}

template <int HW> __device__ __forceinline__ void pool_chunk(const bf16_t* u, bf16_t* pooled, int s0, int c) {
#pragma unroll 1
    for (int blk = 0; blk < 8; ++blk) { const int sb = s0 + blk * 8;
        float v0[8 + 2 * HW], v1[8 + 2 * HW];
#pragma unroll
        for (int i = 0; i < 8 + 2 * HW; ++i) { const int j = sb - HW + i; const bool ok = (j >= 0) && (j < S); const int jc = ok ? j : sb;
            const unsigned w = *(const unsigned*)(u + (size_t)jc * 1024 + c); v0[i] = ok ? bf_lo(w) : 0.f; v1[i] = ok ? bf_hi(w) : 0.f; }
        float a0 = 0.f, a1 = 0.f;
#pragma unroll
        for (int i = 0; i < 2 * HW; ++i) { a0 += v0[i]; a1 += v1[i]; }
#pragma unroll
        for (int i = 0; i < 8; ++i) { const int s_ = sb + i; a0 += v0[i + 2 * HW]; a1 += v1[i + 2 * HW];
            const int hi_ = s_ + HW + 1 < S ? s_ + HW + 1 : S, lo_ = s_ - HW > 0 ? s_ - HW : 0; const float ic = 1.0f / (float)(hi_ - lo_);
            *(unsigned*)(pooled + (size_t)s_ * 1024 + c) = cvt_pk_bf16(a0 * ic - v0[i + HW], a1 * ic - v1[i + HW]);
            a0 -= v0[i]; a1 -= v1[i]; }
    }
}


#define XB_TMO      128
#define XB_XCNT(j)  (256  + 64 * (j))
#define XB_XSUB(j)  (1280 + 64 * (j))
#define XB_XGEN(j)  (2304 + 64 * (j))
#define XB_TOP      3328
#define XB_TOPGEN   3392
#define XCD_BAR_WORDS 3456
#define XB_SPIN_CAP (1u << 18)

__device__ __forceinline__ unsigned xb_ld(unsigned* p)              { return __hip_atomic_load(p, __ATOMIC_RELAXED, __HIP_MEMORY_SCOPE_AGENT); }
__device__ __forceinline__ unsigned xb_add(unsigned* p, unsigned v) { return __hip_atomic_fetch_add(p, v, __ATOMIC_RELAXED, __HIP_MEMORY_SCOPE_AGENT); }
__device__ __forceinline__ unsigned xb_xcc_id() { return (unsigned)__builtin_amdgcn_s_getreg((3 << 11) | 20) & 0xFu; }
#define XB_SPIN(cond, bar) do { unsigned _sp = 0; while (cond) { __builtin_amdgcn_s_sleep(1); \
    if ((++_sp & 255u) == 0u) { if (xb_ld(&(bar)[XB_TMO])) break; if (_sp > XB_SPIN_CAP) { atomicAdd(&(bar)[XB_TMO], 1u); break; } } } } while (0)

struct XcdBarrier {
    unsigned* bar; unsigned x;
    volatile LAS unsigned* st;
};

__device__ __forceinline__ XcdBarrier xcd_barrier_post(unsigned* bar, volatile LAS unsigned* st) {
    XcdBarrier b; b.bar = bar; b.x = xb_xcc_id(); b.st = st;
    if (threadIdx.x == 0) (void)xb_add(&bar[XB_XCNT(b.x)], 1u);
    return b;
}
__device__ __forceinline__ void xcd_barrier_complete(unsigned* bar, unsigned x, unsigned& nloc, unsigned& nx) {
    const unsigned G = gridDim.x * gridDim.y * gridDim.z;
    unsigned sum, cnt, mine, sp = 0u;
    for (;;) {
        sum = 0u; cnt = 0u; mine = 0u;
#pragma unroll
        for (unsigned j = 0; j < 16; ++j) { const unsigned c = xb_ld(&bar[XB_XCNT(j)]); sum += c; cnt += (c > 0u) ? 1u : 0u; mine = (j == x) ? c : mine; }
        if (sum == G) break;
        __builtin_amdgcn_s_sleep(1);
        if ((++sp & 255u) == 0u) { if (xb_ld(&bar[XB_TMO])) break; if (sp > XB_SPIN_CAP) { atomicAdd(&bar[XB_TMO], 1u); break; } }
    }
    nloc = mine > 0u ? mine : 1u; nx = cnt > 0u ? cnt : 1u;
}

__device__ __forceinline__ void xcd_barrier(const XcdBarrier& b, const bool t0) {
    asm volatile("s_waitcnt vmcnt(0)" ::: "memory");
    __syncthreads();
    if (t0) {
        unsigned* bar = b.bar;
        __builtin_amdgcn_s_waitcnt(0);
        unsigned nloc = b.st[0], nx = b.st[1];
        if (nloc == 0u) { xcd_barrier_complete(bar, b.x, nloc, nx); b.st[0] = nloc; b.st[1] = nx; }
        const unsigned old = xb_add(&bar[XB_XSUB(b.x)], 1u);
        const unsigned gen = old / nloc;
        if (old + 1u == (gen + 1u) * nloc) {
            __builtin_amdgcn_fence(__ATOMIC_RELEASE, "agent");
            asm volatile("s_waitcnt vmcnt(0)" ::: "memory");
            const unsigned og = xb_add(&bar[XB_TOP], 1u);
            const unsigned tg = og / nx;
            if (og + 1u == (tg + 1u) * nx) xb_add(&bar[XB_TOPGEN], 1u);
            else XB_SPIN(xb_ld(&bar[XB_TOPGEN]) == tg, bar);
            __builtin_amdgcn_fence(__ATOMIC_ACQUIRE, "agent");
            xb_add(&bar[XB_XGEN(b.x)], 1u);
            asm volatile("s_waitcnt vmcnt(0)" ::: "memory");
        } else {
            XB_SPIN(xb_ld(&bar[XB_XGEN(b.x)]) == gen, bar);
            __builtin_amdgcn_fence(__ATOMIC_ACQUIRE, "agent");
            asm volatile("s_waitcnt vmcnt(0)" ::: "memory");
        }
    }
    __syncthreads();
}


__device__ __forceinline__ void cvt_bf16_fp8(const bf16_t* src, unsigned char* dst, int nitems, int i0, int stride) {
    for (int i = i0; i < nitems; i += 4 * stride) { u32x4 w[4];
#pragma unroll
        for (int j = 0; j < 4; ++j) { const int k = i + j * stride; w[j] = *(const u32x4*)(src + (size_t)(k < nitems ? k : i) * 8); }
#pragma unroll
        for (int j = 0; j < 4; ++j) { const int k = i + j * stride;
            const f32x4 a0 = (f32x4){bf_lo(w[j].x), bf_hi(w[j].x), bf_lo(w[j].y), bf_hi(w[j].y)} * 64.0f, a1 = (f32x4){bf_lo(w[j].z), bf_hi(w[j].z), bf_lo(w[j].w), bf_hi(w[j].w)} * 64.0f;
            u32x2 q; q.x = pk_fp8x4(a0); q.y = pk_fp8x4(a1); if (k < nitems) *(u32x2*)(dst + (size_t)k * 8) = q; } }
}

struct Args {
    const float* x; const float* mem; const int* pos;
    const float *f1n, *f1g, *f1u, *f1d, *mixn, *win, *bgate, *poolw, *pools, *memn, *wkv, *wupp, *wupa, *wupm, *wout, *f2n, *f2g, *f2u, *f2d, *finn;
    float* out; unsigned char* ws; int ph_lo, ph_hi;
};
constexpr int NPH = 12;
constexpr int LDS_TOTAL = STAGE_BYTES + 64;
template <class T> __device__ __forceinline__ T arg_ld(const void* base, int off) { asm volatile("" : "+s"(off)); return *(const T*)((const char*)base + off); }
#define ARG(f) arg_ld<decltype(Args::f)>(&a, (int)offsetof(Args, f))


__global__ void __launch_bounds__(512, 2) fwd_kernel(Args a) {
    extern __shared__ __attribute__((aligned(16))) unsigned char lds_raw[];
    LAS unsigned char* lds = (LAS unsigned char*)lds_raw;
    volatile LAS unsigned* bst = (volatile LAS unsigned*)(lds + STAGE_BYTES);
    if (threadIdx.x < 2) bst[threadIdx.x] = 0u;
    __syncthreads();
    const int wave = __builtin_amdgcn_readfirstlane(threadIdx.x >> 6);
    if (ARG(ph_lo) < 0) cg::this_grid().sync();
#define lane lane_id()
#define tid (wave * 64 + lane_id())
    const int G = gridDim.x, bid = blockIdx.x, gw = bid * 8 + wave, nw = G * 8;
    unsigned char* const ws = ARG(ws);
    XcdBarrier xbar; xbar.bar = (unsigned*)(ws + WS_BAR); xbar.x = 0; xbar.st = bst;
    if (ARG(ph_hi) - ARG(ph_lo) > 1) xbar = xcd_barrier_post((unsigned*)(ws + WS_BAR), bst);
#define P_Wgu    ((bf16_t*)(ws + WS_WA))
#define P_Wd     ((bf16_t*)(ws + WS_WA + 44 * MiB))
#define P_og     ((bf16_t*)(ws + WS_WA))
#define P_ao     ((bf16_t*)(ws + WS_WA + 48 * MiB))
#define P_Win    ((bf16_t*)(ws + WS_WIN))
#define P_Wkv    ((bf16_t*)(ws + WS_WKV))
#define P_Wupp   ((bf16_t*)(ws + WS_WUPP))
#define P_Wupa   ((bf16_t*)(ws + WS_WUPA))
#define P_Wupm   ((bf16_t*)(ws + WS_WUPM))
#define P_Wout   ((bf16_t*)(ws + WS_WOUT))
#define P_Wpool  ((bf16_t*)(ws + WS_WPOOL))
#define P_act    ((bf16_t*)(ws + WS_R2))
#define P_ub     ((bf16_t*)(ws + WS_R2))
#define P_qb_    ((bf16_t*)(ws + WS_R2 + 32 * MiB))
#define P_kb_    ((bf16_t*)(ws + WS_R2 + 80 * MiB))
#define P_vtb    ((bf16_t*)(ws + WS_R2 + 128 * MiB))
#define P_qmb    ((bf16_t*)(ws + WS_R2 + 176 * MiB))
#define P_gates  ((bf16_t*)(ws + WS_R2))
#define P_h      ((bf16_t*)(ws + WS_R3))
#define P_merged ((bf16_t*)(ws + WS_R3))
#define P_pooled ((bf16_t*)(ws + WS_R5))
#define P_mo     ((bf16_t*)(ws + WS_R5 + 32 * MiB))
#define P_pmb    ((bf16_t*)(ws + WS_R5 + 64 * MiB))
#define P_cs     ((float*)(ws + WS_COS))
#define P_sn     ((float*)(ws + WS_SIN))
#define P_memn   ((bf16_t*)(ws + WS_MEMN))
#define P_kmk    ((bf16_t*)(ws + WS_KVMK))
#define P_vmt    ((bf16_t*)(ws + WS_VMT))
#define P_lse    ((float*)(ws + WS_LSE))
#define P_x1b    ((bf16_t*)ARG(out))
#define P_x2b    ((bf16_t*)ARG(out) + (size_t)S * D)
#define P_h8     ((unsigned char*)ARG(out) + 64 * MiB)
#define P_ao8    ((unsigned char*)ARG(out) + 96 * MiB)
#define P_mo8    ((unsigned char*)ARG(out) + 104 * MiB)
#define P_Wupa8  ((unsigned char*)ARG(out) + 120 * MiB)
#define P_Wupm8  ((unsigned char*)ARG(out) + 121 * MiB)
#define P_Wg8    ((unsigned char*)(ws + WS_WG8))
#define P_W8b    ((unsigned char*)(ws + WS_W8B))
#define P_x3b    ((bf16_t*)(ws + WS_R3))
#define IN(p) (ARG(ph_lo) <= (p) && (p) < ARG(ph_hi))
#define PHASE_REP(p) for (int rep_ = 0; rep_ < ((p) == PROBE_PH ? 2 : 1); ++rep_)
#define REPSYNC do { if (rep_ > 0) xcd_barrier(xbar, wave == 0 && lane_id() == 0); } while (0)
#define SEAM(p) do { if (ARG(ph_lo) <= (p) && (p) + 1 < ARG(ph_hi)) { xcd_barrier(xbar, wave == 0 && lane_id() == 0); } } while (0)

    if (IN(0)) PHASE_REP(0) { REPSYNC;
        int rot = 0;
        cvt_matrix(lds, ARG(f1g), D, FF, P_Wgu, 3, rot, bid, G, tid, wave, lane);
        cvt_matrix(lds, ARG(f1u), D, FF, P_Wgu, 4, rot, bid, G, tid, wave, lane);
        cvt_matrix(lds, ARG(f1d), FF, D, P_Wd, 1, rot, bid, G, tid, wave, lane);
        cvt_matrix(lds, ARG(win), D, INC, P_Win, 2, rot, bid, G, tid, wave, lane);
        cvt_matrix(lds, ARG(wkv), D, 2048, P_Wkv, 5, rot, bid, G, tid, wave, lane);
        cvt_matrix(lds, ARG(wupp), 1024, D, P_Wupp, 1, rot, bid, G, tid, wave, lane);
        cvt_matrix(lds, ARG(wupa), 512, D, P_Wupa, 1, rot, bid, G, tid, wave, lane);
        cvt_matrix(lds, ARG(wupm), 1024, D, P_Wupm, 1, rot, bid, G, tid, wave, lane);
        cvt_matrix(lds, ARG(wout), D, D, P_Wout, 1, rot, bid, G, tid, wave, lane);
        for (int gp = 0; gp < 4; ++gp) cvt_matrix(lds, ARG(poolw) + gp * 65536, 256, 256, P_Wpool + gp * 65536, 1, rot, bid, G, tid, wave, lane);
        for (int i = bid * 512 + tid; i < S * 64; i += G * 512) { const int s_ = i >> 6, f = i & 63;
            const float inv = powf(10000.0f, -(float)f / 64.0f); const float ang = (float)ARG(pos)[s_] * inv; float sv, cv; sincosf(ang, &sv, &cv); P_cs[i] = cv; P_sn[i] = sv; }
        rmsnorm_rows<true>(ARG(x), ARG(f1n), P_h, S, gw, nw, lane);
        rmsnorm_rows<true>(ARG(mem), ARG(memn), P_memn, NMEM, gw, nw, lane);
    }
    SEAM(0);
    if (IN(1)) PHASE_REP(1) { REPSYNC;
        Gemm g{P_h, P_Wgu, D, D, S, 2 * FF, D}; StaticOrder so; so.init(S, 2 * FF, G, bid);
        gemm_phase<EpiGU, 0>(lds, g, so, EpiGU{P_act}, wave);
    }
    SEAM(1);
    if (IN(2)) PHASE_REP(2) { REPSYNC;
        Gemm g{P_act, P_Wd, FF, FF, S, D, FF}; StaticOrder so; so.init(S, D, G, bid);
        gemm_phase<EpiResB<true>, 0>(lds, g, so, EpiResB<true>{ARG(x), P_x1b, 0.5f, 0}, wave);
    }
    SEAM(2);
    if (IN(3)) PHASE_REP(3) { REPSYNC;
        {
            const int t0 = bid * 512 + tid, ts = G * 512;
            cvt_bf16_fp8(P_Win + (size_t)6656 * D, P_Wg8, 6144 * D / 8, t0, ts);
            cvt_bf16_fp8(P_Win + (size_t)1024 * D, P_W8b, 5632 * D / 8, t0, ts);
            cvt_bf16_fp8(P_Wupa, P_Wupa8, 512 * D / 8, t0, ts);
            cvt_bf16_fp8(P_Wupm, P_Wupm8, 1024 * D / 8, t0, ts);
        }
        rmsnorm_rows_b<true>(P_x1b, ARG(mixn), P_h, S, gw, nw, lane, P_h8);
    }
    SEAM(3);
    if (IN(4)) PHASE_REP(4) { REPSYNC;
        { Gemm g{P_h, P_Win, D, D, S, 1024, D}; StaticOrder so; so.init(S, 1024, G, bid);
          gemm_phase<EpiProj, 0>(lds, g, so, EpiProj{P_ub, P_qb_, P_kb_, P_qmb, P_cs, P_sn, 0.f, 0.f, 0.f, 0}, wave); }
        { Gemm g{(const bf16_t*)P_h8, (const bf16_t*)P_W8b, D / 2, D / 2, S, 4096, D / 2}; StaticOrder so; so.init(S, 4096, G, bid);
          gemm_phase<EpiProj, 0, true>(lds, g, so, EpiProj{P_ub, P_qb_, P_kb_, P_qmb, P_cs, P_sn, LOG2E * 0.08838834764831845f / 64.0f, LOG2E * 0.0625f / 64.0f, 1.0f / 64.0f, 4}, wave); }
        const int G2 = G / 2; const bf16_t* const wv8 = (const bf16_t*)(P_W8b + (size_t)4096 * D);
        if (bid < G2) { Gemm g{wv8, (const bf16_t*)P_h8, D / 2, D / 2, 512, S, D / 2}; StaticOrder so; so.init(512, S, G2, bid); gemm_phase<EpiVt<1>, 1, true>(lds, g, so, EpiVt<1>{P_vtb, 1.0f / 64.0f, 0}, wave); }
        else { Gemm g{wv8 + (size_t)512 * (D / 2), (const bf16_t*)P_h8, D / 2, D / 2, 512, S, D / 2}; StaticOrder so; so.init(512, S, G - G2, bid - G2); gemm_phase<EpiVt<4>, 4, true>(lds, g, so, EpiVt<4>{P_vtb + (size_t)4 * S * 128, 1.0f / 64.0f, 0}, wave); }
        if (bid < G2) { Gemm g{wv8 + (size_t)1024 * (D / 2), (const bf16_t*)P_h8, D / 2, D / 2, 512, S, D / 2}; StaticOrder so; so.init(512, S, G2, bid); gemm_phase<EpiVt<16>, 16, true>(lds, g, so, EpiVt<16>{P_vtb + (size_t)8 * S * 128, 1.0f / 64.0f, 0}, wave); }
        else if (bid - G2 < 4) { Gemm g{P_memn, P_Wkv, D, D, NMEM, 1024, D}; StaticOrder so; so.init(NMEM, 1024, 4, bid - G2); gemm_phase<EpiKvmK, 0>(lds, g, so, EpiKvmK{P_kmk}, wave); }
        else if (bid - G2 < 8) { Gemm g{P_Wkv + (size_t)1024 * D, P_memn, D, D, 1024, NMEM, D}; StaticOrder so; so.init(1024, NMEM, 4, bid - G2 - 4); gemm_phase<EpiKvmVt, 1>(lds, g, so, EpiKvmVt{P_vmt}, wave); }
    }
    SEAM(4);
    if (IN(5)) PHASE_REP(5) { REPSYNC;
        for (int T = gw; T < 12288 * DBG_ATT; T += nw) attn_tile(P_qb_, P_kb_, P_vtb, P_og, P_lse, T, lane);
        for (int un = bid; un < 512; un += G) mem_unit(lds, P_qmb, P_kmk, P_vmt, P_mo, P_mo8, un, tid, wave, lane);
        {
            const int gp = wave >> 1;
            for (int c0 = bid; c0 < S / 64; c0 += G) {
                if (gp == 0) pool_chunk<1>(P_ub, P_pooled, c0 * 64, 2 * tid);
                else if (gp == 1) pool_chunk<2>(P_ub, P_pooled, c0 * 64, 2 * tid);
                else if (gp == 2) pool_chunk<4>(P_ub, P_pooled, c0 * 64, 2 * tid);
                else pool_chunk<8>(P_ub, P_pooled, c0 * 64, 2 * tid);
            }
        }
    }
    SEAM(5);
    if (IN(6)) PHASE_REP(6) { REPSYNC;
        for (int i0 = bid * 512 + tid; i0 < S * 64; i0 += 4 * G * 512) {
            float l_[4][3]; u32x4 x_[4][3];
#pragma unroll
            for (int j = 0; j < 4; ++j) { const int ij = i0 + j * G * 512, i = ij < S * 64 ? ij : i0; const int t = i >> 6, col = (i & 63) * 8, hg = col >> 7;
#pragma unroll
                for (int g_ = 0; g_ < 3; ++g_) { l_[j][g_] = P_lse[((size_t)g_ * S + t) * 4 + hg]; x_[j][g_] = *(const u32x4*)(P_og + ((size_t)g_ * S + t) * 512 + col); } }
#pragma unroll
            for (int j = 0; j < 4; ++j) { const int i = i0 + j * G * 512; const int t = i >> 6, col = (i & 63) * 8;
                const float l0_ = l_[j][0], l1_ = l_[j][1], l2_ = l_[j][2]; const u32x4 x0 = x_[j][0], x1 = x_[j][1], x2 = x_[j][2];
                const float mm = fmaxf(l0_, fmaxf(l1_, l2_)); float w0 = fast_exp2(l0_ - mm), w1 = fast_exp2(l1_ - mm), w2 = fast_exp2(l2_ - mm); const float iw = 1.0f / (w0 + w1 + w2); w0 *= iw; w1 *= iw; w2 *= iw;
                u32x4 o_;
                o_.x = cvt_pk_bf16(w0 * bf_lo(x0.x) + w1 * bf_lo(x1.x) + w2 * bf_lo(x2.x), w0 * bf_hi(x0.x) + w1 * bf_hi(x1.x) + w2 * bf_hi(x2.x));
                o_.y = cvt_pk_bf16(w0 * bf_lo(x0.y) + w1 * bf_lo(x1.y) + w2 * bf_lo(x2.y), w0 * bf_hi(x0.y) + w1 * bf_hi(x1.y) + w2 * bf_hi(x2.y));
                o_.z = cvt_pk_bf16(w0 * bf_lo(x0.z) + w1 * bf_lo(x1.z) + w2 * bf_lo(x2.z), w0 * bf_hi(x0.z) + w1 * bf_hi(x1.z) + w2 * bf_hi(x2.z));
                o_.w = cvt_pk_bf16(w0 * bf_lo(x0.w) + w1 * bf_lo(x1.w) + w2 * bf_lo(x2.w), w0 * bf_hi(x0.w) + w1 * bf_hi(x1.w) + w2 * bf_hi(x2.w));
                const f32x4 a0 = (f32x4){bf_lo(o_.x), bf_hi(o_.x), bf_lo(o_.y), bf_hi(o_.y)} * 16.0f, a1 = (f32x4){bf_lo(o_.z), bf_hi(o_.z), bf_lo(o_.w), bf_hi(o_.w)} * 16.0f;
                u32x2 q; q.x = pk_fp8x4(a0); q.y = pk_fp8x4(a1); if (i < S * 64) *(u32x2*)(P_ao8 + (size_t)t * 512 + col) = q; } }
        { const int G4 = G / 4, gp = bid / G4 < 3 ? bid / G4 : 3, c = bid - gp * G4, gn = gp < 3 ? G4 : G - 3 * G4;
          Gemm g{P_pooled + gp * 256, P_Wpool + gp * 65536, 1024, 256, S, 256, 256}; StaticOrder so; so.init(S, 256, gn, c);
          gemm_phase<EpiPm, 0>(lds, g, so, EpiPm{P_pmb, ARG(pools), gp}, wave); }
        { Gemm g{(const bf16_t*)P_h8, (const bf16_t*)P_Wg8, D / 2, D / 2, S, 3 * D, D / 2}; StaticOrder so; so.init(S, 3 * D, G, bid);
          gemm_phase<EpiGate, 0, true>(lds, g, so, EpiGate{P_gates, ARG(bgate), 1.0f / 64.0f, 0}, wave); }
    }
    SEAM(6);
    if (IN(7)) PHASE_REP(7) { REPSYNC;
        StaticOrder so; so.init(S, D, G, bid);
        { Gemm g{P_pmb, P_Wupp, 1024, 1024, S, D, 1024}; gemm_phase<EpiUp, 0>(lds, g, so, EpiUp{P_merged, P_gates, 0, 1.0f}, wave); }
        { Gemm g{(const bf16_t*)P_ao8, (const bf16_t*)P_Wupa8, 256, 256, S, D, 256}; gemm_phase<EpiUp, 0, true>(lds, g, so, EpiUp{P_merged, P_gates, 1, 1.0f / 1024.0f}, wave); }
        { Gemm g{(const bf16_t*)P_mo8, (const bf16_t*)P_Wupm8, 512, 512, S, D, 512}; gemm_phase<EpiUp, 0, true>(lds, g, so, EpiUp{P_merged, P_gates, 2, 1.0f / 1024.0f}, wave); }
    }
    SEAM(7);
    if (IN(8)) PHASE_REP(8) { REPSYNC;
        Gemm g{P_merged, P_Wout, D, D, S, D, D}; StaticOrder so; so.init(S, D, G, bid);
        gemm_phase<EpiResB<false>, 0>(lds, g, so, EpiResB<false>{P_x1b, P_x2b, 1.0f, 0}, wave);
    }
    SEAM(8);
    if (IN(9)) PHASE_REP(9) { REPSYNC;
        int rot = 0;
        cvt_matrix(lds, ARG(f2g), D, FF, P_Wgu, 3, rot, bid, G, tid, wave, lane);
        cvt_matrix(lds, ARG(f2u), D, FF, P_Wgu, 4, rot, bid, G, tid, wave, lane);
        cvt_matrix(lds, ARG(f2d), FF, D, P_Wd, 1, rot, bid, G, tid, wave, lane);
        rmsnorm_rows_b<true>(P_x2b, ARG(f2n), P_h, S, gw, nw, lane);
    }
    SEAM(9);
    if (IN(10)) PHASE_REP(10) { REPSYNC;
        Gemm g{P_h, P_Wgu, D, D, S, 2 * FF, D}; StaticOrder so; so.init(S, 2 * FF, G, bid);
        gemm_phase<EpiGU, 0>(lds, g, so, EpiGU{P_act}, wave);
    }
    SEAM(10);
    if (IN(11)) PHASE_REP(11) { REPSYNC;
        Gemm g{P_act, P_Wd, FF, FF, S, D, FF}; StaticOrder so; so.init(S, D, G, bid);
        gemm_phase<EpiResB<false>, 0>(lds, g, so, EpiResB<false>{P_x2b, P_x3b, 0.5f, 0}, wave);
    }
    SEAM(11);
    if (IN(12)) rmsnorm_rows_b<false>(P_x3b, ARG(finn), ARG(out), S, gw, nw, lane);
#undef IN
#undef SEAM
#undef lane
#undef tid
}


#ifndef DBG_UPTO
#define DBG_UPTO 12
#endif
#ifndef DBG_FOLD
#define DBG_FOLD 0
#endif
__global__ void dbg_fold(const unsigned short* w, float* out, size_t nws, int n) {
    for (int i = blockIdx.x * blockDim.x + threadIdx.x; i < n; i += gridDim.x * blockDim.x) {
        unsigned acc_ = 0; for (size_t j = (size_t)i; j < nws; j += (size_t)n) acc_ += w[j];
        out[i] = (float)acc_;
    }
}
#ifndef N_LAUNCH_MODE
#define N_LAUNCH_MODE 1
#endif

extern "C" void kernel_launch(void* const* d_in, const int* in_sizes, int n_in, void* d_out, int out_size, void* d_ws, size_t ws_size, hipStream_t stream) {
    static int grid = 0;
    if (grid == 0) {
        if (n_in != 23 || ws_size < WS_END) { fprintf(stderr, "kernel_launch: unexpected n_in %d or ws_size %zu (< %zu)\n", n_in, ws_size, (size_t)WS_END); grid = -1; return; }
        int dev = 0, cus = 0, per_cu = 0;
        hipGetDevice(&dev); hipDeviceGetAttribute(&cus, hipDeviceAttributeMultiprocessorCount, dev);
        if (hipFuncSetAttribute((const void*)fwd_kernel, hipFuncAttributeMaxDynamicSharedMemorySize, LDS_TOTAL) != hipSuccess) { fprintf(stderr, "kernel_launch: hipFuncSetAttribute failed\n"); grid = -1; return; }
        hipOccupancyMaxActiveBlocksPerMultiprocessor(&per_cu, (const void*)fwd_kernel, 512, LDS_TOTAL);
        if (per_cu < 1) { fprintf(stderr, "kernel_launch: occupancy query says %d\n", per_cu); per_cu = 1; }
        (void)hipGetLastError();
        grid = cus * 1;
    }
    if (grid < 0) return;
    if (hipMemsetAsync((char*)d_ws + WS_BAR, 0, XCD_BAR_WORDS * 4, stream) != hipSuccess) { fprintf(stderr, "kernel_launch: memset failed\n"); return; }
    Args a{};
    a.x = (const float*)d_in[0]; a.mem = (const float*)d_in[1]; a.pos = (const int*)d_in[2];
    a.f1n = (const float*)d_in[3]; a.f1g = (const float*)d_in[4]; a.f1u = (const float*)d_in[5]; a.f1d = (const float*)d_in[6];
    a.mixn = (const float*)d_in[7]; a.win = (const float*)d_in[8]; a.bgate = (const float*)d_in[9]; a.poolw = (const float*)d_in[10]; a.pools = (const float*)d_in[11];
    a.memn = (const float*)d_in[12]; a.wkv = (const float*)d_in[13]; a.wupp = (const float*)d_in[14]; a.wupa = (const float*)d_in[15]; a.wupm = (const float*)d_in[16]; a.wout = (const float*)d_in[17];
    a.f2n = (const float*)d_in[18]; a.f2g = (const float*)d_in[19]; a.f2u = (const float*)d_in[20]; a.f2d = (const float*)d_in[21]; a.finn = (const float*)d_in[22];
    a.out = (float*)d_out; a.ws = (unsigned char*)d_ws;
#if N_LAUNCH_MODE == 1
    a.ph_lo = 0; a.ph_hi = NPH + 1;
    void* args[] = {&a};
    hipError_t e = hipLaunchCooperativeKernel((const void*)fwd_kernel, dim3(grid), dim3(512), args, LDS_TOTAL, stream);
    if (e != hipSuccess) fprintf(stderr, "cooperative launch failed: %s (grid %d)\n", hipGetErrorString(e), grid);
#else
    for (int p = 0; p <= NPH && p <= DBG_UPTO; ++p) { a.ph_lo = p; a.ph_hi = p + 1; hipLaunchKernelGGL(fwd_kernel, dim3(grid), dim3(512), LDS_TOTAL, stream, a); }
#if DBG_FOLD
    hipLaunchKernelGGL(dbg_fold, dim3(2048), dim3(256), 0, stream, (const unsigned short*)d_ws, (float*)d_out, (size_t)(WS_END / 2), out_size);
#endif
#endif
}
```

```cpp
#include <hip/hip_runtime.h>
#include <hip/hip_cooperative_groups.h>
#include <cstdio>
namespace cg = cooperative_groups;

#define LAS __attribute__((address_space(3)))
typedef unsigned short bf16_t;
typedef short bf16x8 __attribute__((ext_vector_type(8)));
typedef float f32x4 __attribute__((ext_vector_type(4)));
typedef unsigned u32x4 __attribute__((ext_vector_type(4)));
typedef unsigned u32x2 __attribute__((ext_vector_type(2)));

constexpr int S = 16384, D = 2048, FF = 5632, NMEM = 256;
constexpr int INC = 12800;
#define DBG_ATT 1
#ifndef PROBE_PH
#define PROBE_PH 99
#endif
constexpr float EPS = 1e-6f;
constexpr float LOG2E = 1.4426950408889634f;
constexpr size_t MiB = 1ull << 20;
constexpr size_t WS_WA   = 0;
constexpr size_t WS_WIN  = WS_WA + 66 * MiB;
constexpr size_t WS_WKV  = WS_WIN + 50 * MiB;
constexpr size_t WS_WUPP = WS_WKV + 8 * MiB;
constexpr size_t WS_WUPA = WS_WUPP + 4 * MiB;
constexpr size_t WS_WUPM = WS_WUPA + 2 * MiB;
constexpr size_t WS_WOUT = WS_WUPM + 4 * MiB;
constexpr size_t WS_WPOOL = WS_WOUT + 8 * MiB;
constexpr size_t WS_R2   = WS_WPOOL + 1 * MiB;
constexpr size_t WS_R3   = WS_R2 + 208 * MiB;
constexpr size_t WS_R5   = WS_R3 + 64 * MiB;
constexpr size_t WS_COS  = WS_R5 + 96 * MiB;
constexpr size_t WS_SIN  = WS_COS + 4 * MiB;
constexpr size_t WS_MEMN = WS_SIN + 4 * MiB;
constexpr size_t WS_KVMK = WS_MEMN + 1 * MiB;
constexpr size_t WS_VMT  = WS_KVMK + MiB / 2;
constexpr size_t WS_LSE  = WS_VMT + MiB / 2;
constexpr size_t WS_BAR  = WS_LSE + 1 * MiB;
constexpr size_t WS_WG8  = WS_BAR + 1 * MiB;
constexpr size_t WS_W8B  = WS_WG8 + 12 * MiB;
constexpr size_t WS_END  = WS_W8B + 11 * MiB;

typedef float f32x2 __attribute__((ext_vector_type(2)));
typedef __bf16 bf16x2v __attribute__((ext_vector_type(2)));
__device__ __forceinline__ unsigned cvt_pk_bf16(float lo, float hi) { const f32x2 v = {lo, hi}; const bf16x2v b = __builtin_convertvector(v, bf16x2v); return __builtin_bit_cast(unsigned, b); }
__device__ __forceinline__ float bf_lo(unsigned w) { return __uint_as_float(w << 16); }
__device__ __forceinline__ float bf_hi(unsigned w) { return __uint_as_float(w & 0xffff0000u); }
__device__ __forceinline__ unsigned pk_fp8x4(f32x4 v) { unsigned w = __builtin_amdgcn_cvt_pk_fp8_f32(v[0], v[1], 0, false); return __builtin_amdgcn_cvt_pk_fp8_f32(v[2], v[3], w, true); }
__device__ __forceinline__ int lane_id() { return (int)__builtin_amdgcn_mbcnt_hi(~0u, __builtin_amdgcn_mbcnt_lo(~0u, 0u)); }
__device__ __forceinline__ float fast_exp2(float x) { return __builtin_amdgcn_exp2f(x); }
__device__ __forceinline__ float fast_rcp(float x) { return __builtin_amdgcn_rcpf(x); }

constexpr int BM = 256, BK = 64, HALF = 128, HTB = HALF * BK * 2, STAGE_BYTES = 8 * HTB, NXCD = 8, WGM = 4;
__device__ __forceinline__ int lds_byte(int r, int c) { const int st = (r >> 4) * 2 + (c >> 5), rr = r & 15, cc = c & 31, ob = rr * 64 + cc * 2; return st * 1024 + (ob ^ (((ob >> 9) & 1) << 5)); }
__device__ __forceinline__ void stage_rc(int b, int& R, int& C) { const int st = b / 1024, sb = b % 1024, swz = sb ^ (((sb >> 9) & 1) << 5); R = (st >> 1) * 16 + swz / 64; C = (st & 1) * 32 + (swz % 64) / 2; }
__device__ __forceinline__ int perm32(int rho) { const int n = rho >> 4, i = rho & 15; return 8 * (i >> 2) + 4 * n + (i & 3); }
__host__ __device__ __forceinline__ int permb(int c) { return (c & ~31) + 16 * ((c >> 2) & 1) + 4 * ((c & 31) >> 3) + (c & 3); }

struct Unit { int pm, pn; };
struct Gemm { const bf16_t* A; const bf16_t* Bt; int lda, ldb, M, N, K; };
struct StaticOrder {
    int nM, nN, nwg, G, c;
    __device__ void init(int M, int N, int G_, int c_) { nM = M / BM; nN = N / BM; nwg = nM * nN; G = G_; c = c_; }
    __device__ bool next(int i, Unit& u) const {
        const long L = (long)i * G + c; if (L >= nwg) return false;
        int wgid = (int)L; { const int q = nwg / NXCD, r = nwg % NXCD, xcd = wgid % NXCD, off = wgid / NXCD; wgid = (xcd < r ? xcd * (q + 1) : r * (q + 1) + (xcd - r) * q) + off; }
        const int nig = WGM * nN, gid = wgid / nig, fm = gid * WGM, gsz = (nM - fm) < WGM ? (nM - fm) : WGM;
        u.pm = fm + ((wgid % nig) % gsz); u.pn = (wgid % nig) / gsz; return true;
    }
};

template <int BP> __device__ __forceinline__ int bperm_row(int R) {
    if (BP == 0) return R;
    const int v = (R & ~31) + perm32(R & 31);
    if (BP == 1) return v;
    constexpr int per = 256 / (BP > 1 ? BP : 2);
    const int r = v / per, l = v % per;
    return l * BP + r;
}

typedef int i32x4 __attribute__((ext_vector_type(4)));
typedef int i32x8 __attribute__((ext_vector_type(8)));
__device__ __forceinline__ i32x8 cat8(bf16x8 a, bf16x8 b) { return __builtin_shufflevector(__builtin_bit_cast(i32x4, a), __builtin_bit_cast(i32x4, b), 0, 1, 2, 3, 4, 5, 6, 7); }
__device__ __forceinline__ void mfma_fp8_inplace(f32x4& c, const i32x8 a, const i32x8 b) { asm volatile("v_mfma_f32_16x16x128_f8f6f4 %0, %1, %2, %0" : "+v"(c) : "v"(a), "v"(b)); }
template <class Epi, int BP, bool FP8 = false>
__device__ __forceinline__ void gemm_phase(LAS unsigned char* lds, const Gemm g, const StaticOrder& S_, const Epi& E, const int wid) {
    const int lane = lane_id(), tid = wid * 64 + lane, wr = wid >> 2, wc = wid & 3, fr = lane & 15, fq = lane >> 4;
    int K_ = g.K; asm volatile("" : "+s"(K_));
    const int K = K_, nt = K / BK;
    unsigned voffA, voffB;
    { int R, C; stage_rc(tid * 16, R, C); voffA = (unsigned)(R * g.lda + C) * 2u; voffB = (unsigned)(bperm_row<BP>(R) * g.ldb + C) * 2u; }
    const size_t d64A = (size_t)64 * g.lda * 2, d64B = (size_t)(BP <= 1 ? 64 : BP / 4) * g.ldb * 2;
    const size_t kstep = (size_t)(BK * 2);
    const size_t hstepA = (size_t)HALF * g.lda * 2;
    const size_t hstepB = (size_t)(BP <= 1 ? HALF : BP / 2) * g.ldb * 2;
    const size_t tstepA = (size_t)BM * g.lda * 2, tstepB = (size_t)BM * g.ldb * 2;
    const unsigned ldsw = (unsigned)wid * 1024u;
    const int aoff = lds_byte(wr * 64 + fr, FP8 ? fq * 16 : fq * 8), boff = lds_byte(wc * 32 + fr, FP8 ? fq * 16 : fq * 8);
    constexpr int KOFF = FP8 ? 16 : 1024;
#define PG8_SA(b, h) (((b) * 2 + (h)) * HTB)
#define PG8_SB(b, h) ((4 + (b) * 2 + (h)) * HTB)
#define PG8_STAGE(bufoff, gbase, voff) do { _Pragma("unroll") for (int _i = 0; _i < 2; ++_i) \
        __builtin_amdgcn_global_load_lds((const unsigned*)((const char*)(gbase) + (size_t)_i * (&(voff) == &voffA ? d64A : d64B) + (voff)), (LAS unsigned*)(lds + (bufoff) + ldsw + _i * 8192), 16, 0, 0); } while (0)
#define PG8_LDA(dst, b, h) do { if constexpr (FP8) { _Pragma("unroll") for (int m = 0; m < 4; ++m) dst##8[m] = cat8(*(const LAS bf16x8*)(lds + PG8_SA(b, h) + aoff + m * 2048), *(const LAS bf16x8*)(lds + PG8_SA(b, h) + aoff + m * 2048 + 16)); } \
        else { _Pragma("unroll") for (int m = 0; m < 4; ++m) _Pragma("unroll") for (int k = 0; k < 2; ++k) dst[m][k] = *(const LAS bf16x8*)(lds + PG8_SA(b, h) + aoff + m * 2048 + k * KOFF); } } while (0)
#define PG8_LDB(dst, b, h) do { if constexpr (FP8) { _Pragma("unroll") for (int n = 0; n < 2; ++n) dst##8[n] = cat8(*(const LAS bf16x8*)(lds + PG8_SB(b, h) + boff + n * 2048), *(const LAS bf16x8*)(lds + PG8_SB(b, h) + boff + n * 2048 + 16)); } \
        else { _Pragma("unroll") for (int n = 0; n < 2; ++n) _Pragma("unroll") for (int k = 0; k < 2; ++k) dst[n][k] = *(const LAS bf16x8*)(lds + PG8_SB(b, h) + boff + n * 2048 + k * KOFF); } } while (0)
#define PG8_MMA(ai, bj, At, Bt) do { __builtin_amdgcn_s_setprio(1); \
        if constexpr (FP8) { _Pragma("unroll") for (int m = 0; m < 4; ++m) _Pragma("unroll") for (int n = 0; n < 2; ++n) \
            mfma_fp8_inplace(acc[ai][bj][m][n], Bt##8[n], At##8[m]); } \
        else { _Pragma("unroll") for (int m = 0; m < 4; ++m) _Pragma("unroll") for (int n = 0; n < 2; ++n) _Pragma("unroll") for (int k = 0; k < 2; ++k) \
            acc[ai][bj][m][n] = __builtin_amdgcn_mfma_f32_16x16x32_bf16(Bt[n][k], At[m][k], acc[ai][bj][m][n], 0, 0, 0); } \
        __builtin_amdgcn_s_setprio(0); } while (0)
#define PG8_WAIT_V(n) asm volatile("s_waitcnt vmcnt(" #n ")" ::: "memory")
#define PG8_WAIT_L(n) asm volatile("s_waitcnt lgkmcnt(" #n ")" ::: "memory")
#define PG8_BAR __builtin_amdgcn_s_barrier()
#define PG8_SCHED __builtin_amdgcn_sched_barrier(0)
    Unit cur, nxt; int ui = 0;
    if (!S_.next(0, cur)) return;
    f32x4 acc[2][2][4][2];
#pragma unroll
    for (int a = 0; a < 2; ++a)
#pragma unroll
        for (int b = 0; b < 2; ++b)
#pragma unroll
            for (int m = 0; m < 4; ++m)
#pragma unroll
                for (int n = 0; n < 2; ++n) acc[a][b][m][n] = (f32x4){0.f, 0.f, 0.f, 0.f};
    bf16x8 At[4][2], B0[2][2], B1[2][2]; i32x8 At8[4], B08[2], B18[2];
    const char* cA = (const char*)g.A + (size_t)cur.pm * tstepA; const char* cB = (const char*)g.Bt + (size_t)cur.pn * tstepB;
    PG8_STAGE(PG8_SB(0, 0), cB, voffB); PG8_STAGE(PG8_SA(0, 0), cA, voffA); PG8_STAGE(PG8_SB(0, 1), cB + hstepB, voffB); PG8_STAGE(PG8_SA(0, 1), cA + hstepA, voffA);
    if (wr == 1) PG8_BAR;
    PG8_WAIT_V(4); PG8_BAR;
    PG8_STAGE(PG8_SB(1, 0), cB + kstep, voffB); PG8_STAGE(PG8_SA(1, 0), cA + kstep, voffA); PG8_STAGE(PG8_SB(1, 1), cB + hstepB + kstep, voffB);
    PG8_WAIT_V(6); PG8_BAR;
    for (;;) {
        const bool has_next = S_.next(ui + 1, nxt);
        const char* nA = has_next ? (const char*)g.A + (size_t)nxt.pm * tstepA : cA; const char* nB = has_next ? (const char*)g.Bt + (size_t)nxt.pn * tstepB : cB;
        for (int t = 0; t < nt; t += 2) {
            const bool last = (t == nt - 2);
            const char* a1 = cA + (size_t)(t + 1) * kstep;
            const char* a2 = last ? nA : cA + (size_t)(t + 2) * kstep; const char* b2 = last ? nB : cB + (size_t)(t + 2) * kstep;
            const char* a3 = a2 + kstep; const char* b3 = b2 + kstep;
            PG8_LDB(B0, 0, 0); PG8_SCHED; PG8_LDA(At, 0, 0); PG8_STAGE(PG8_SA(1, 1), a1 + hstepA, voffA);
            PG8_WAIT_L(8); PG8_BAR; PG8_WAIT_L(0); PG8_MMA(0, 0, At, B0); PG8_BAR; PG8_SCHED;
            PG8_LDB(B1, 0, 1); PG8_STAGE(PG8_SB(0, 0), b2, voffB);
            PG8_BAR; PG8_WAIT_L(0); PG8_MMA(0, 1, At, B1); PG8_BAR;
            PG8_LDA(At, 0, 1); PG8_STAGE(PG8_SA(0, 0), a2, voffA);
            PG8_BAR; PG8_WAIT_L(0); PG8_MMA(1, 0, At, B0); PG8_BAR; PG8_SCHED;
            PG8_STAGE(PG8_SB(0, 1), b2 + hstepB, voffB);
            PG8_WAIT_V(6); PG8_BAR; PG8_MMA(1, 1, At, B1); PG8_BAR;
            PG8_LDB(B0, 1, 0); PG8_SCHED; PG8_LDA(At, 1, 0); PG8_STAGE(PG8_SA(0, 1), a2 + hstepA, voffA);
            PG8_WAIT_L(8); PG8_BAR; PG8_WAIT_L(0); PG8_MMA(0, 0, At, B0); PG8_BAR; PG8_SCHED;
            PG8_LDB(B1, 1, 1); PG8_STAGE(PG8_SB(1, 0), b3, voffB);
            PG8_BAR; PG8_WAIT_L(0); PG8_MMA(0, 1, At, B1); PG8_BAR;
            PG8_LDA(At, 1, 1); PG8_STAGE(PG8_SA(1, 0), a3, voffA);
            PG8_BAR; PG8_WAIT_L(0); PG8_MMA(1, 0, At, B0); PG8_BAR; PG8_SCHED;
            PG8_STAGE(PG8_SB(1, 1), b3 + hstepB, voffB);
            PG8_WAIT_V(6); PG8_BAR; PG8_MMA(1, 1, At, B1); PG8_BAR;
        }
        if constexpr (FP8) asm volatile("s_nop 15\n\ts_nop 15" ::: "memory");
        { const int ln_ = __builtin_amdgcn_mbcnt_hi(~0u, __builtin_amdgcn_mbcnt_lo(~0u, 0u)); E(acc, cur, wr, wc, ln_ & 15, ln_ >> 4); }
        if (!has_next) break;
#pragma unroll
        for (int a = 0; a < 2; ++a)
#pragma unroll
            for (int b = 0; b < 2; ++b)
#pragma unroll
                for (int m = 0; m < 4; ++m)
#pragma unroll
                    for (int n = 0; n < 2; ++n) acc[a][b][m][n] = (f32x4){0.f, 0.f, 0.f, 0.f};
        cur = nxt; cA = nA; cB = nB; ++ui;
    }
    PG8_WAIT_V(0);
    if (wr == 0) PG8_BAR;
    PG8_BAR;
#undef PG8_SA
#undef PG8_SB
#undef PG8_STAGE
#undef PG8_LDA
#undef PG8_LDB
#undef PG8_MMA
#undef PG8_WAIT_V
#undef PG8_WAIT_L
#undef PG8_BAR
#undef PG8_SCHED
}

typedef f32x4 AccT[2][2][4][2];
__device__ __forceinline__ u32x4 pack8(f32x4 a, f32x4 b) { u32x4 w; w.x = cvt_pk_bf16(a[0], a[1]); w.y = cvt_pk_bf16(a[2], a[3]); w.z = cvt_pk_bf16(b[0], b[1]); w.w = cvt_pk_bf16(b[2], b[3]); return w; }
__device__ __forceinline__ u32x2 pack4(f32x4 a) { u32x2 w; w.x = cvt_pk_bf16(a[0], a[1]); w.y = cvt_pk_bf16(a[2], a[3]); return w; }

struct EpiGU { bf16_t* act;
    __device__ __forceinline__ void operator()(const AccT& acc, const Unit& u, int wr, int wc, int fr, int fq) const {
        const int row0 = u.pm * BM + wr * 64 + fr, col0 = u.pn * 128 + wc * 32 + 8 * fq;
#pragma unroll
        for (int ai = 0; ai < 2; ++ai)
#pragma unroll
            for (int m = 0; m < 4; ++m) { f32x4 v[2];
#pragma unroll
                for (int n = 0; n < 2; ++n) { const f32x4 gt = acc[ai][0][m][n], up = acc[ai][1][m][n];
#pragma unroll
                    for (int j = 0; j < 4; ++j) v[n][j] = gt[j] * fast_rcp(1.0f + fast_exp2(-gt[j] * LOG2E)) * up[j]; }
                *(u32x4*)(act + (size_t)(row0 + ai * HALF + m * 16) * FF + col0) = pack8(v[0], v[1]); }
    }
};
struct EpiRes { const float* xin; float* xout; float alpha;
    __device__ __forceinline__ void operator()(const AccT& acc, const Unit& u, int wr, int wc, int fr, int fq) const {
        const int row0 = u.pm * BM + wr * 64 + fr, col0 = u.pn * BM + wc * 32 + 4 * fq;
#pragma unroll
        for (int ai = 0; ai < 2; ++ai)
#pragma unroll
            for (int m = 0; m < 4; ++m) { const size_t off = (size_t)(row0 + ai * HALF + m * 16) * D + col0;
#pragma unroll
                for (int bj = 0; bj < 2; ++bj)
#pragma unroll
                    for (int n = 0; n < 2; ++n) { const f32x4 b = *(const f32x4*)(xin + off + bj * HALF + n * 16); *(f32x4*)(xout + off + bj * HALF + n * 16) = b + alpha * acc[ai][bj][m][n]; }
                asm volatile("" ::: "memory"); }
    }
};
template <bool XF32> struct EpiResB { const void* xin; bf16_t* xout; float alpha; int pad_;
    __device__ __forceinline__ void operator()(const AccT& acc, const Unit& u, int wr, int wc, int fr, int fq) const {
        const int row0 = u.pm * BM + wr * 64 + fr, col0 = u.pn * BM + wc * 32 + 8 * fq;
        const float al = alpha; const float* const xf = (const float*)xin; const bf16_t* const xb = (const bf16_t*)xin; bf16_t* const xo = xout;
#pragma unroll
        for (int ai = 0; ai < 2; ++ai) {
            f32x4 b0[4][2], b1[4][2];
#pragma unroll
            for (int m = 0; m < 4; ++m) { const size_t off = (size_t)(row0 + ai * HALF + m * 16) * D + col0;
#pragma unroll
                for (int bj = 0; bj < 2; ++bj) {
                    if (XF32) { b0[m][bj] = *(const f32x4*)(xf + off + bj * HALF); b1[m][bj] = *(const f32x4*)(xf + off + bj * HALF + 4); }
                    else { const u32x4 w = *(const u32x4*)(xb + off + bj * HALF); b0[m][bj] = (f32x4){bf_lo(w.x), bf_hi(w.x), bf_lo(w.y), bf_hi(w.y)}; b1[m][bj] = (f32x4){bf_lo(w.z), bf_hi(w.z), bf_lo(w.w), bf_hi(w.w)}; } } }
#pragma unroll
            for (int m = 0; m < 4; ++m) { const size_t off = (size_t)(row0 + ai * HALF + m * 16) * D + col0;
#pragma unroll
                for (int bj = 0; bj < 2; ++bj) *(u32x4*)(xo + off + bj * HALF) = pack8(b0[m][bj] + al * acc[ai][bj][m][0], b1[m][bj] + al * acc[ai][bj][m][1]); } }
    }
};
__device__ __forceinline__ void epi_plain(const AccT& acc, bf16_t* O, int ldc, int rowt, int colt, float scale, int wr, int wc, int fr, int fq) {
    const int row0 = rowt + wr * 64 + fr, col0 = colt + wc * 32 + 8 * fq;
#pragma unroll
    for (int ai = 0; ai < 2; ++ai)
#pragma unroll
        for (int m = 0; m < 4; ++m) { bf16_t* rowp = O + (size_t)(row0 + ai * HALF + m * 16) * ldc + col0;
#pragma unroll
            for (int bj = 0; bj < 2; ++bj) *(u32x4*)(rowp + bj * HALF) = pack8(acc[ai][bj][m][0] * scale, acc[ai][bj][m][1] * scale); }
}
struct EpiProj { bf16_t *u, *q, *k, *qm; const float* cs; const float* sn; float qscale, qmscale, kscale; int pn_off;
    __device__ __forceinline__ void operator()(const AccT& acc, const Unit& un, int wr, int wc, int fr, int fq) const {
        const int pn = un.pn + pn_off;
        if (pn < 4) { epi_plain(acc, u, 1024, un.pm * BM, pn * BM, 1.0f, wr, wc, fr, fq); return; }
        if (pn >= 16) { epi_plain(acc, qm, 1024, un.pm * BM, (pn - 16) * BM, qmscale, wr, wc, fr, fq); return; }
        const bool isq = pn < 10; bf16_t* base = isq ? q : k; const int colt = (pn - (isq ? 4 : 10)) * BM; const float sc = isq ? qscale : kscale;
        const int row0 = un.pm * BM + wr * 64 + fr, d0 = 16 * wc + 4 * fq;
#pragma unroll
        for (int ai = 0; ai < 2; ++ai)
#pragma unroll
            for (int m = 0; m < 4; ++m) { const int row = row0 + ai * HALF + m * 16;
                const f32x4 c = *(const f32x4*)(cs + (size_t)row * 64 + d0) * sc, s = *(const f32x4*)(sn + (size_t)row * 64 + d0) * sc;
#pragma unroll
                for (int bj = 0; bj < 2; ++bj) { const f32x4 t1 = acc[ai][bj][m][0], t2 = acc[ai][bj][m][1];
                    bf16_t* p = base + (size_t)row * 1536 + colt + bj * HALF + d0;
                    *(u32x2*)p = pack4(t1 * c - t2 * s); *(u32x2*)(p + 64) = pack4(t2 * c + t1 * s); } }
    }
};
template <int DIL> struct EpiVt { bf16_t* vt; float sc; int pad_;
    __device__ __forceinline__ void operator()(const AccT& acc, const Unit& u, int wr, int wc, int fr, int fq) const {
        constexpr int per = 256 / DIL, L8 = S / DIL / 8;
#pragma unroll
        for (int bj = 0; bj < 2; ++bj) { const int v0 = bj * HALF + wc * 32 + 8 * fq, r = v0 / per, l = per * u.pn + (v0 % per);
#pragma unroll
            for (int ai = 0; ai < 2; ++ai)
#pragma unroll
                for (int m = 0; m < 4; ++m) { const int grow = u.pm * BM + ai * HALF + wr * 64 + m * 16 + fr, hg = grow >> 7, dim = grow & 127;
                    *(u32x4*)(vt + ((((size_t)hg * DIL + r) * L8 + (l >> 3)) * 128 + dim) * 8) = pack8(acc[ai][bj][m][0] * sc, acc[ai][bj][m][1] * sc); } }
    }
};
struct EpiGate { bf16_t* gates; const float* bias; float ascale; int pad_;
    __device__ __forceinline__ void operator()(const AccT& acc, const Unit& u, int wr, int wc, int fr, int fq) const {
        const int row0 = u.pm * BM + wr * 64 + fr, col0 = u.pn * BM + wc * 32 + 8 * fq;
#pragma unroll
        for (int bj = 0; bj < 2; ++bj) { const f32x4 b0 = *(const f32x4*)(bias + col0 + bj * HALF), b1 = *(const f32x4*)(bias + col0 + bj * HALF + 4);
#pragma unroll
            for (int ai = 0; ai < 2; ++ai)
#pragma unroll
                for (int m = 0; m < 4; ++m) { f32x4 v0 = acc[ai][bj][m][0] * ascale + b0, v1 = acc[ai][bj][m][1] * ascale + b1;
#pragma unroll
                    for (int j = 0; j < 4; ++j) { v0[j] = fast_rcp(1.0f + fast_exp2(-v0[j] * LOG2E)); v1[j] = fast_rcp(1.0f + fast_exp2(-v1[j] * LOG2E)); }
                    *(u32x4*)(gates + (size_t)(row0 + ai * HALF + m * 16) * (3 * D) + col0 + bj * HALF) = pack8(v0, v1); } }
    }
};
struct EpiPm { bf16_t* pm; const float* scale; int g;
    __device__ __forceinline__ void operator()(const AccT& acc, const Unit& u, int wr, int wc, int fr, int fq) const {
        const int row0 = u.pm * BM + wr * 64 + fr, col0 = g * 256 + wc * 32 + 8 * fq;
#pragma unroll
        for (int bj = 0; bj < 2; ++bj) { const f32x4 s0 = *(const f32x4*)(scale + col0 + bj * HALF), s1 = *(const f32x4*)(scale + col0 + bj * HALF + 4);
#pragma unroll
            for (int ai = 0; ai < 2; ++ai)
#pragma unroll
                for (int m = 0; m < 4; ++m)
                    *(u32x4*)(pm + (size_t)(row0 + ai * HALF + m * 16) * 1024 + col0 + bj * HALF) = pack8(acc[ai][bj][m][0] * s0, acc[ai][bj][m][1] * s1); }
    }
};
struct EpiUp { bf16_t* merged; const bf16_t* gates; int b; float sc;
    __device__ __forceinline__ void operator()(const AccT& acc, const Unit& u, int wr, int wc, int fr, int fq) const {
        const int row0 = u.pm * BM + wr * 64 + fr, col0 = u.pn * BM + wc * 32 + 8 * fq;
        const int bb = b; const float s_ = sc; bf16_t* const mg = merged; const bf16_t* const gt = gates;
#pragma unroll
        for (int ai = 0; ai < 2; ++ai) {
            u32x4 gw[4][2], pw[4][2];
#pragma unroll
            for (int m = 0; m < 4; ++m) { const size_t row = (size_t)(row0 + ai * HALF + m * 16);
#pragma unroll
                for (int bj = 0; bj < 2; ++bj) { gw[m][bj] = *(const u32x4*)(gt + row * (3 * D) + bb * D + col0 + bj * HALF);
                    pw[m][bj] = bb > 0 ? *(const u32x4*)(mg + row * D + col0 + bj * HALF) : (u32x4){0u, 0u, 0u, 0u}; } }
#pragma unroll
            for (int m = 0; m < 4; ++m) { const size_t row = (size_t)(row0 + ai * HALF + m * 16);
#pragma unroll
                for (int bj = 0; bj < 2; ++bj) { const u32x4 g_ = gw[m][bj], p_ = pw[m][bj];
                    const f32x4 p0 = (f32x4){bf_lo(p_.x), bf_hi(p_.x), bf_lo(p_.y), bf_hi(p_.y)}, p1 = (f32x4){bf_lo(p_.z), bf_hi(p_.z), bf_lo(p_.w), bf_hi(p_.w)};
                    const f32x4 g0 = (f32x4){bf_lo(g_.x), bf_hi(g_.x), bf_lo(g_.y), bf_hi(g_.y)}, g1 = (f32x4){bf_lo(g_.z), bf_hi(g_.z), bf_lo(g_.w), bf_hi(g_.w)};
                    *(u32x4*)(mg + row * D + col0 + bj * HALF) = pack8(p0 + g0 * (acc[ai][bj][m][0] * s_), p1 + g1 * (acc[ai][bj][m][1] * s_)); } } }
    }
};
struct EpiKvmK { bf16_t* kk;
    __device__ __forceinline__ void operator()(const AccT& acc, const Unit& u, int wr, int wc, int fr, int fq) const { epi_plain(acc, kk, 1024, u.pm * BM, u.pn * BM, 1.0f, wr, wc, fr, fq); }
};
struct EpiKvmVt { bf16_t* vmt;
    __device__ __forceinline__ void operator()(const AccT& acc, const Unit& u, int wr, int wc, int fr, int fq) const {
#pragma unroll
        for (int bj = 0; bj < 2; ++bj) { const int tb = (bj * HALF + wc * 32 + 8 * fq) >> 3;
#pragma unroll
            for (int ai = 0; ai < 2; ++ai)
#pragma unroll
                for (int m = 0; m < 4; ++m) { const int grow = u.pm * BM + ai * HALF + wr * 64 + m * 16 + fr, hm = grow >> 8, dim = grow & 255;
                    *(u32x4*)(vmt + (((size_t)hm * 32 + tb) * 256 + dim) * 8) = pack8(acc[ai][bj][m][0], acc[ai][bj][m][1]); } }
    }
};

template <bool OUT_BF16>
__device__ __forceinline__ void rmsnorm_rows(const float* x, const float* g, void* out, int nrows, int wave0, int nwaves, int lane) {
    for (int r = wave0; r < nrows; r += 2 * nwaves) {
        const int r2 = r + nwaves; const bool two = r2 < nrows;
        const float* xr = x + (size_t)r * D; const float* xq = x + (size_t)(two ? r2 : r) * D; f32x4 v[8], w[8]; float ss = 0.f, st = 0.f;
#pragma unroll
        for (int c = 0; c < 8; ++c) v[c] = *(const f32x4*)(xr + (c * 64 + lane) * 4);
#pragma unroll
        for (int c = 0; c < 8; ++c) w[c] = *(const f32x4*)(xq + (c * 64 + lane) * 4);
#pragma unroll
        for (int c = 0; c < 8; ++c) { ss += v[c][0] * v[c][0] + v[c][1] * v[c][1] + v[c][2] * v[c][2] + v[c][3] * v[c][3]; st += w[c][0] * w[c][0] + w[c][1] * w[c][1] + w[c][2] * w[c][2] + w[c][3] * w[c][3]; }
#pragma unroll
        for (int o = 32; o >= 1; o >>= 1) { ss += __shfl_xor(ss, o); st += __shfl_xor(st, o); }
        const float rs = 1.0f / sqrtf(ss * (1.0f / D) + EPS), rt = 1.0f / sqrtf(st * (1.0f / D) + EPS);
#pragma unroll
        for (int c = 0; c < 8; ++c) { const f32x4 gg = *(const f32x4*)(g + (c * 64 + lane) * 4); const f32x4 y = v[c] * rs * gg, z = w[c] * rt * gg;
            if (OUT_BF16) { *(u32x2*)((bf16_t*)out + (size_t)r * D + (c * 64 + lane) * 4) = pack4(y); if (two) *(u32x2*)((bf16_t*)out + (size_t)r2 * D + (c * 64 + lane) * 4) = pack4(z); }
            else { *(f32x4*)((float*)out + (size_t)r * D + (c * 64 + lane) * 4) = y; if (two) *(f32x4*)((float*)out + (size_t)r2 * D + (c * 64 + lane) * 4) = z; } }
    }
}

template <bool OUT_BF16>
__device__ __forceinline__ void rmsnorm_rows_b(const bf16_t* x, const float* g, void* out, int nrows, int wave0, int nwaves, int lane, unsigned char* out8 = nullptr) {
    for (int r = wave0; r < nrows; r += 2 * nwaves) {
        const int r2 = r + nwaves; const bool two = r2 < nrows;
        const bf16_t* xr = x + (size_t)r * D; const bf16_t* xq = x + (size_t)(two ? r2 : r) * D; u32x4 v[4], w[4]; float ss = 0.f, st = 0.f;
#pragma unroll
        for (int c = 0; c < 4; ++c) v[c] = *(const u32x4*)(xr + (c * 64 + lane) * 8);
#pragma unroll
        for (int c = 0; c < 4; ++c) w[c] = *(const u32x4*)(xq + (c * 64 + lane) * 8);
        f32x4 a[4][2], b[4][2];
#pragma unroll
        for (int c = 0; c < 4; ++c) { a[c][0] = (f32x4){bf_lo(v[c].x), bf_hi(v[c].x), bf_lo(v[c].y), bf_hi(v[c].y)}; a[c][1] = (f32x4){bf_lo(v[c].z), bf_hi(v[c].z), bf_lo(v[c].w), bf_hi(v[c].w)};
            b[c][0] = (f32x4){bf_lo(w[c].x), bf_hi(w[c].x), bf_lo(w[c].y), bf_hi(w[c].y)}; b[c][1] = (f32x4){bf_lo(w[c].z), bf_hi(w[c].z), bf_lo(w[c].w), bf_hi(w[c].w)};
#pragma unroll
            for (int k = 0; k < 2; ++k) { ss += a[c][k][0] * a[c][k][0] + a[c][k][1] * a[c][k][1] + a[c][k][2] * a[c][k][2] + a[c][k][3] * a[c][k][3];
                st += b[c][k][0] * b[c][k][0] + b[c][k][1] * b[c][k][1] + b[c][k][2] * b[c][k][2] + b[c][k][3] * b[c][k][3]; } }
#pragma unroll
        for (int o = 32; o >= 1; o >>= 1) { ss += __shfl_xor(ss, o); st += __shfl_xor(st, o); }
        const float rs = 1.0f / sqrtf(ss * (1.0f / D) + EPS), rt = 1.0f / sqrtf(st * (1.0f / D) + EPS);
#pragma unroll
        for (int c = 0; c < 4; ++c) { const int e0 = (c * 64 + lane) * 8; const f32x4 g0 = *(const f32x4*)(g + e0), g1 = *(const f32x4*)(g + e0 + 4);
            const f32x4 y0 = a[c][0] * rs * g0, y1 = a[c][1] * rs * g1, z0 = b[c][0] * rt * g0, z1 = b[c][1] * rt * g1;
            if (OUT_BF16) { *(u32x4*)((bf16_t*)out + (size_t)r * D + e0) = pack8(y0, y1); if (two) *(u32x4*)((bf16_t*)out + (size_t)r2 * D + e0) = pack8(z0, z1);
                if (out8) { u32x2 q; q.x = pk_fp8x4(y0); q.y = pk_fp8x4(y1); *(u32x2*)(out8 + (size_t)r * D + e0) = q; if (two) { u32x2 q2; q2.x = pk_fp8x4(z0); q2.y = pk_fp8x4(z1); *(u32x2*)(out8 + (size_t)r2 * D + e0) = q2; } } }
            else { float* o1 = (float*)out + (size_t)r * D + e0; *(f32x4*)o1 = y0; *(f32x4*)(o1 + 4) = y1;
                   if (two) { float* o2 = (float*)out + (size_t)r2 * D + e0; *(f32x4*)o2 = z0; *(f32x4*)(o2 + 4) = z1; } } }
    }
}

__device__ __forceinline__ int rope_slot(int d) { const int n = d >> 6, dd = d & 63; return 32 * (dd >> 4) + 16 * n + (dd & 15); }
__device__ __forceinline__ int slot_of(int mode, int c) {
    switch (mode) {
    case 0: return c;
    case 1: return permb(c);
    case 2: if (c < 1024) return permb(c);
            if (c < 2560) { const int x = c - 1024; return 1024 + (x & ~127) + rope_slot(x & 127); }
            if (c < 4096) { const int x = c - 2560; return 2560 + (x & ~127) + rope_slot(x & 127); }
            if (c < 5632) return 5120 + (c - 4096);
            if (c < 6656) return 4096 + permb(c - 5632);
            return 6656 + permb(c - 6656);
    case 3: return 256 * (c >> 7) + permb(c & 127);
    case 4: return 256 * (c >> 7) + 128 + permb(c & 127);
    default: return c < 1024 ? permb(c) : c;
    }
}
__device__ __forceinline__ void cvt_matrix(LAS unsigned char* lds, const float* src, int Ks, int Ns, bf16_t* dst, int mode, int& rot, int bid, int G, int tid, int wave, int lane) {
    const int nkt = Ks / 64, ntiles = nkt * (Ns / 256);
    int t = (bid + G - rot) % G; rot = (rot + ntiles) % G; if (t >= ntiles) return;
    float v[8][4];
    { const int kt = t % nkt, cn = t / nkt; const float* p = src + (size_t)(kt * 64 + wave * 8) * Ns + cn * 256 + lane;
#pragma unroll
      for (int i = 0; i < 8; ++i)
#pragma unroll
          for (int j = 0; j < 4; ++j) v[i][j] = p[(size_t)i * Ns + 64 * j]; }
    for (;;) {
        const int kt = t % nkt, cn = t / nkt;
#pragma unroll
        for (int j = 0; j < 4; ++j) { u32x4 w; w.x = cvt_pk_bf16(v[0][j], v[1][j]); w.y = cvt_pk_bf16(v[2][j], v[3][j]); w.z = cvt_pk_bf16(v[4][j], v[5][j]); w.w = cvt_pk_bf16(v[6][j], v[7][j]);
            *(LAS u32x4*)(lds + (lane + 64 * j) * 144 + wave * 16) = w; }
        const int tn = t + G;
        if (tn < ntiles) { const int kt2 = tn % nkt, cn2 = tn / nkt; const float* p = src + (size_t)(kt2 * 64 + wave * 8) * Ns + cn2 * 256 + lane;
#pragma unroll
            for (int i = 0; i < 8; ++i)
#pragma unroll
                for (int j = 0; j < 4; ++j) v[i][j] = p[(size_t)i * Ns + 64 * j]; }
        __syncthreads();
#pragma unroll
        for (int p_ = 0; p_ < 4; ++p_) { const int n = p_ * 64 + (tid >> 3), ch = tid & 7;
            const u32x4 w = *(const LAS u32x4*)(lds + n * 144 + ch * 16);
            *(u32x4*)(dst + (size_t)slot_of(mode, cn * 256 + n) * Ks + kt * 64 + ch * 8) = w; }
        __syncthreads();
        if (tn >= ntiles) break;
        t = tn;
    }
}

__device__ __forceinline__ void attn_tile(const bf16_t* q, const bf16_t* k, const bf16_t* vt, bf16_t* og, float* lse, int T, int lane) {
    const int fr = lane & 15, fq = lane >> 4;
    const int g = T >> 12, Tp = T & 4095, hg = Tp >> 10, Tpp = Tp & 1023;
    const int dsh = 2 * g, d = 1 << dsh, per = 1024 >> dsh, r = Tpp >> (10 - dsh), lb = Tpp & (per - 1), l0 = lb * 16, L = S >> dsh, L8 = L >> 3;
    const int head = g * 4 + hg, lstart = l0 - 64;
    bf16x8 qf[4];
    const int tok = (l0 + fr) * d + r;
    { const bf16_t* p = q + (size_t)tok * 1536 + head * 128 + fq * 8;
#pragma unroll
      for (int kk = 0; kk < 4; ++kk) qf[kk] = *(const bf16x8*)(p + kk * 32); }
    const bf16_t* kbase = k + head * 128 + fq * 8;
    bf16x8 kf[10][4];
#pragma unroll
    for (int kb = 0; kb < 10; ++kb) { int lk = lstart + 32 * (kb >> 1) + 8 * (fr >> 2) + 4 * (kb & 1) + (fr & 3); lk = lk < 0 ? 0 : (lk > L - 1 ? L - 1 : lk);
        const bf16_t* kp = kbase + (size_t)(lk * d + r) * 1536;
#pragma unroll
        for (int kk = 0; kk < 4; ++kk) kf[kb][kk] = *(const bf16x8*)(kp + kk * 32); }
    f32x4 st[10];
#pragma unroll
    for (int kb = 0; kb < 10; ++kb) { f32x4 a = (f32x4){0.f, 0.f, 0.f, 0.f};
#pragma unroll
        for (int kk = 0; kk < 4; ++kk) a = __builtin_amdgcn_mfma_f32_16x16x32_bf16(kf[kb][kk], qf[kk], a, 0, 0, 0);
        st[kb] = a; }
    const bf16_t* vg = vt + (size_t)g * (4 * (size_t)S * 128) + ((size_t)(hg * d + r) * L8) * 1024 + fr * 8;
    bf16x8 vf[5][8];
#pragma unroll
    for (int ks = 0; ks < 5; ++ks) { int tb = (lstart + 32 * ks + 8 * fq) >> 3; tb = tb < 0 ? 0 : (tb > L8 - 1 ? L8 - 1 : tb); const bf16_t* vp = vg + (size_t)tb * 1024;
#pragma unroll
        for (int db = 0; db < 8; ++db) vf[ks][db] = *(const bf16x8*)(vp + db * 128); }
    float m_ = -3.0e38f;
#pragma unroll
    for (int kb = 0; kb < 10; ++kb)
#pragma unroll
        for (int j = 0; j < 4; ++j) { const int kidx = 32 * (kb >> 1) + 8 * fq + 4 * (kb & 1) + j, lk = lstart + kidx, rel = kidx - 64 - fr;
            const bool ok = (lk >= 0) && (lk < L) && (rel >= -64) && (rel <= 64);
            const float s_ = ok ? st[kb][j] : -3.0e38f; st[kb][j] = s_; m_ = fmaxf(m_, s_); }
    m_ = fmaxf(m_, __shfl_xor(m_, 16)); m_ = fmaxf(m_, __shfl_xor(m_, 32));
    float su = 0.f;
#pragma unroll
    for (int kb = 0; kb < 10; ++kb)
#pragma unroll
        for (int j = 0; j < 4; ++j) { const float s_ = st[kb][j]; const float p_ = s_ > -1.0e38f ? fast_exp2(s_ - m_) : 0.f; st[kb][j] = p_; su += p_; }
    su += __shfl_xor(su, 16); su += __shfl_xor(su, 32);
    f32x4 o[8];
#pragma unroll
    for (int db = 0; db < 8; ++db) o[db] = (f32x4){0.f, 0.f, 0.f, 0.f};
#pragma unroll
    for (int ks = 0; ks < 5; ++ks) { const u32x4 w = pack8(st[2 * ks], st[2 * ks + 1]); const bf16x8 pf = __builtin_bit_cast(bf16x8, w);
#pragma unroll
        for (int db = 0; db < 8; ++db) o[db] = __builtin_amdgcn_mfma_f32_16x16x32_bf16(vf[ks][db], pf, o[db], 0, 0, 0); }
    const float inv = 1.0f / su;
    bf16_t* op = og + ((size_t)g * S + tok) * 512 + hg * 128 + 4 * fq;
#pragma unroll
    for (int db = 0; db < 8; ++db) *(u32x2*)(op + db * 16) = pack4(o[db] * inv);
    if (fq == 0) lse[((size_t)g * S + tok) * 4 + hg] = m_ + __log2f(su);
}

__device__ __forceinline__ void mem_unit(LAS unsigned char* lds, const bf16_t* qm, const bf16_t* kmk, const bf16_t* vmt, bf16_t* mo, unsigned char* mo8, int unit, int tid, int wave, int lane) {
    const int fr = lane & 15, fq = lane >> 4;
    const int hm = unit >> 7, tok = (unit & 127) * 128 + wave * 16 + fr;
#pragma unroll 4
    for (int i = 0; i < 16; ++i) { const int ch = tid + i * 512, row = ch >> 5, c = ch & 31;
        const u32x4 w = *(const u32x4*)(kmk + (size_t)row * 1024 + hm * 256 + c * 8);
        *(LAS u32x4*)(lds + row * 512 + ((c ^ ((row & 3) | (((row >> 3) & 3) << 2))) << 4)) = w; }
    bf16x8 qf[8];
    { const bf16_t* p = qm + (size_t)tok * 1024 + hm * 256 + fq * 8;
#pragma unroll
      for (int kk = 0; kk < 8; ++kk) qf[kk] = *(const bf16x8*)(p + kk * 32); }
    __syncthreads();
    bf16x8 pf[8];
    { const int krow0 = 8 * (fr >> 2) + (fr & 3), key4 = fr;
        f32x4 st[16];
#pragma unroll
        for (int kb = 0; kb < 16; ++kb) { const int row = 32 * (kb >> 1) + 4 * (kb & 1) + krow0; f32x4 a = (f32x4){0.f, 0.f, 0.f, 0.f};
#pragma unroll
            for (int kk = 0; kk < 8; ++kk) { const bf16x8 kf = *(const LAS bf16x8*)(lds + row * 512 + (((kk * 4 + fq) ^ key4) << 4));
                a = __builtin_amdgcn_mfma_f32_16x16x32_bf16(kf, qf[kk], a, 0, 0, 0); }
            st[kb] = a; }
        float m_ = -3.0e38f;
#pragma unroll
        for (int kb = 0; kb < 16; ++kb)
#pragma unroll
            for (int j = 0; j < 4; ++j) m_ = fmaxf(m_, st[kb][j]);
        m_ = fmaxf(m_, __shfl_xor(m_, 16)); m_ = fmaxf(m_, __shfl_xor(m_, 32));
        float su = 0.f;
#pragma unroll
        for (int kb = 0; kb < 16; ++kb)
#pragma unroll
            for (int j = 0; j < 4; ++j) { const float p_ = fast_exp2(st[kb][j] - m_); st[kb][j] = p_; su += p_; }
        su += __shfl_xor(su, 16); su += __shfl_xor(su, 32);
        const float inv = 1.0f / su;
#pragma unroll
        for (int ks = 0; ks < 8; ++ks) { const u32x4 w = pack8(st[2 * ks] * inv, st[2 * ks + 1] * inv); pf[ks] = __builtin_bit_cast(bf16x8, w); }
    }
    __syncthreads();
#pragma unroll 4
    for (int i = 0; i < 16; ++i) { const int ch = tid + i * 512;
        *(LAS u32x4*)(lds + ch * 16) = *(const u32x4*)(vmt + (size_t)hm * 65536 + (size_t)ch * 8); }
    __syncthreads();
    bf16_t* op = mo + (size_t)tok * 1024 + hm * 256 + 4 * fq;
#pragma unroll
    for (int db = 0; db < 16; ++db) { f32x4 a = (f32x4){0.f, 0.f, 0.f, 0.f};
#pragma unroll
        for (int ks = 0; ks < 8; ++ks) { const bf16x8 vf = *(const LAS bf16x8*)(lds + (((4 * ks + fq) * 256 + 16 * db + fr) << 4));
            a = __builtin_amdgcn_mfma_f32_16x16x32_bf16(vf, pf[ks], a, 0, 0, 0); }
        *(unsigned*)(mo8 + (size_t)tok * 1024 + hm * 256 + 4 * fq + db * 16) = pk_fp8x4(a * 16.0f); }
    __syncthreads();
}

template <int HW> __device__ __forceinline__ void pool_chunk(const bf16_t* u, bf16_t* pooled, int s0, int c) {
#pragma unroll 1
    for (int blk = 0; blk < 8; ++blk) { const int sb = s0 + blk * 8;
        float v0[8 + 2 * HW], v1[8 + 2 * HW];
#pragma unroll
        for (int i = 0; i < 8 + 2 * HW; ++i) { const int j = sb - HW + i; const bool ok = (j >= 0) && (j < S); const int jc = ok ? j : sb;
            const unsigned w = *(const unsigned*)(u + (size_t)jc * 1024 + c); v0[i] = ok ? bf_lo(w) : 0.f; v1[i] = ok ? bf_hi(w) : 0.f; }
        float a0 = 0.f, a1 = 0.f;
#pragma unroll
        for (int i = 0; i < 2 * HW; ++i) { a0 += v0[i]; a1 += v1[i]; }
#pragma unroll
        for (int i = 0; i < 8; ++i) { const int s_ = sb + i; a0 += v0[i + 2 * HW]; a1 += v1[i + 2 * HW];
            const int hi_ = s_ + HW + 1 < S ? s_ + HW + 1 : S, lo_ = s_ - HW > 0 ? s_ - HW : 0; const float ic = 1.0f / (float)(hi_ - lo_);
            *(unsigned*)(pooled + (size_t)s_ * 1024 + c) = cvt_pk_bf16(a0 * ic - v0[i + HW], a1 * ic - v1[i + HW]);
            a0 -= v0[i]; a1 -= v1[i]; }
    }
}


#define XB_TMO      128
#define XB_XCNT(j)  (256  + 64 * (j))
#define XB_XSUB(j)  (1280 + 64 * (j))
#define XB_XGEN(j)  (2304 + 64 * (j))
#define XB_TOP      3328
#define XB_TOPGEN   3392
#define XCD_BAR_WORDS 3456
#define XB_SPIN_CAP (1u << 18)

__device__ __forceinline__ unsigned xb_ld(unsigned* p)              { return __hip_atomic_load(p, __ATOMIC_RELAXED, __HIP_MEMORY_SCOPE_AGENT); }
__device__ __forceinline__ unsigned xb_add(unsigned* p, unsigned v) { return __hip_atomic_fetch_add(p, v, __ATOMIC_RELAXED, __HIP_MEMORY_SCOPE_AGENT); }
__device__ __forceinline__ unsigned xb_xcc_id() { return (unsigned)__builtin_amdgcn_s_getreg((3 << 11) | 20) & 0xFu; }
#define XB_SPIN(cond, bar) do { unsigned _sp = 0; while (cond) { __builtin_amdgcn_s_sleep(1); \
    if ((++_sp & 255u) == 0u) { if (xb_ld(&(bar)[XB_TMO])) break; if (_sp > XB_SPIN_CAP) { atomicAdd(&(bar)[XB_TMO], 1u); break; } } } } while (0)

struct XcdBarrier {
    unsigned* bar; unsigned x;
    volatile LAS unsigned* st;
};

__device__ __forceinline__ XcdBarrier xcd_barrier_post(unsigned* bar, volatile LAS unsigned* st) {
    XcdBarrier b; b.bar = bar; b.x = xb_xcc_id(); b.st = st;
    if (threadIdx.x == 0) (void)xb_add(&bar[XB_XCNT(b.x)], 1u);
    return b;
}
__device__ __forceinline__ void xcd_barrier_complete(unsigned* bar, unsigned x, unsigned& nloc, unsigned& nx) {
    const unsigned G = gridDim.x * gridDim.y * gridDim.z;
    unsigned sum, cnt, mine, sp = 0u;
    for (;;) {
        sum = 0u; cnt = 0u; mine = 0u;
#pragma unroll
        for (unsigned j = 0; j < 16; ++j) { const unsigned c = xb_ld(&bar[XB_XCNT(j)]); sum += c; cnt += (c > 0u) ? 1u : 0u; mine = (j == x) ? c : mine; }
        if (sum == G) break;
        __builtin_amdgcn_s_sleep(1);
        if ((++sp & 255u) == 0u) { if (xb_ld(&bar[XB_TMO])) break; if (sp > XB_SPIN_CAP) { atomicAdd(&bar[XB_TMO], 1u); break; } }
    }
    nloc = mine > 0u ? mine : 1u; nx = cnt > 0u ? cnt : 1u;
}

__device__ __forceinline__ void xcd_barrier(const XcdBarrier& b, const bool t0) {
    asm volatile("s_waitcnt vmcnt(0)" ::: "memory");
    __syncthreads();
    if (t0) {
        unsigned* bar = b.bar;
        __builtin_amdgcn_s_waitcnt(0);
        unsigned nloc = b.st[0], nx = b.st[1];
        if (nloc == 0u) { xcd_barrier_complete(bar, b.x, nloc, nx); b.st[0] = nloc; b.st[1] = nx; }
        const unsigned old = xb_add(&bar[XB_XSUB(b.x)], 1u);
        const unsigned gen = old / nloc;
        if (old + 1u == (gen + 1u) * nloc) {
            __builtin_amdgcn_fence(__ATOMIC_RELEASE, "agent");
            asm volatile("s_waitcnt vmcnt(0)" ::: "memory");
            const unsigned og = xb_add(&bar[XB_TOP], 1u);
            const unsigned tg = og / nx;
            if (og + 1u == (tg + 1u) * nx) xb_add(&bar[XB_TOPGEN], 1u);
            else XB_SPIN(xb_ld(&bar[XB_TOPGEN]) == tg, bar);
            __builtin_amdgcn_fence(__ATOMIC_ACQUIRE, "agent");
            xb_add(&bar[XB_XGEN(b.x)], 1u);
            asm volatile("s_waitcnt vmcnt(0)" ::: "memory");
        } else {
            XB_SPIN(xb_ld(&bar[XB_XGEN(b.x)]) == gen, bar);
            __builtin_amdgcn_fence(__ATOMIC_ACQUIRE, "agent");
            asm volatile("s_waitcnt vmcnt(0)" ::: "memory");
        }
    }
    __syncthreads();
}


__device__ __forceinline__ void cvt_bf16_fp8(const bf16_t* src, unsigned char* dst, int nitems, int i0, int stride) {
    for (int i = i0; i < nitems; i += 4 * stride) { u32x4 w[4];
#pragma unroll
        for (int j = 0; j < 4; ++j) { const int k = i + j * stride; w[j] = *(const u32x4*)(src + (size_t)(k < nitems ? k : i) * 8); }
#pragma unroll
        for (int j = 0; j < 4; ++j) { const int k = i + j * stride;
            const f32x4 a0 = (f32x4){bf_lo(w[j].x), bf_hi(w[j].x), bf_lo(w[j].y), bf_hi(w[j].y)} * 64.0f, a1 = (f32x4){bf_lo(w[j].z), bf_hi(w[j].z), bf_lo(w[j].w), bf_hi(w[j].w)} * 64.0f;
            u32x2 q; q.x = pk_fp8x4(a0); q.y = pk_fp8x4(a1); if (k < nitems) *(u32x2*)(dst + (size_t)k * 8) = q; } }
}

struct Args {
    const float* x; const float* mem; const int* pos;
    const float *f1n, *f1g, *f1u, *f1d, *mixn, *win, *bgate, *poolw, *pools, *memn, *wkv, *wupp, *wupa, *wupm, *wout, *f2n, *f2g, *f2u, *f2d, *finn;
    float* out; unsigned char* ws; int ph_lo, ph_hi;
};
constexpr int NPH = 12;
constexpr int LDS_TOTAL = STAGE_BYTES + 64;
template <class T> __device__ __forceinline__ T arg_ld(const void* base, int off) { asm volatile("" : "+s"(off)); return *(const T*)((const char*)base + off); }
#define ARG(f) arg_ld<decltype(Args::f)>(&a, (int)offsetof(Args, f))


__global__ void __launch_bounds__(512, 2) fwd_kernel(Args a) {
    extern __shared__ __attribute__((aligned(16))) unsigned char lds_raw[];
    LAS unsigned char* lds = (LAS unsigned char*)lds_raw;
    volatile LAS unsigned* bst = (volatile LAS unsigned*)(lds + STAGE_BYTES);
    if (threadIdx.x < 2) bst[threadIdx.x] = 0u;
    __syncthreads();
    const int wave = __builtin_amdgcn_readfirstlane(threadIdx.x >> 6);
    if (ARG(ph_lo) < 0) cg::this_grid().sync();
#define lane lane_id()
#define tid (wave * 64 + lane_id())
    const int G = gridDim.x, bid = blockIdx.x, gw = bid * 8 + wave, nw = G * 8;
    unsigned char* const ws = ARG(ws);
    XcdBarrier xbar; xbar.bar = (unsigned*)(ws + WS_BAR); xbar.x = 0; xbar.st = bst;
    if (ARG(ph_hi) - ARG(ph_lo) > 1) xbar = xcd_barrier_post((unsigned*)(ws + WS_BAR), bst);
#define P_Wgu    ((bf16_t*)(ws + WS_WA))
#define P_Wd     ((bf16_t*)(ws + WS_WA + 44 * MiB))
#define P_og     ((bf16_t*)(ws + WS_WA))
#define P_ao     ((bf16_t*)(ws + WS_WA + 48 * MiB))
#define P_Win    ((bf16_t*)(ws + WS_WIN))
#define P_Wkv    ((bf16_t*)(ws + WS_WKV))
#define P_Wupp   ((bf16_t*)(ws + WS_WUPP))
#define P_Wupa   ((bf16_t*)(ws + WS_WUPA))
#define P_Wupm   ((bf16_t*)(ws + WS_WUPM))
#define P_Wout   ((bf16_t*)(ws + WS_WOUT))
#define P_Wpool  ((bf16_t*)(ws + WS_WPOOL))
#define P_act    ((bf16_t*)(ws + WS_R2))
#define P_ub     ((bf16_t*)(ws + WS_R2))
#define P_qb_    ((bf16_t*)(ws + WS_R2 + 32 * MiB))
#define P_kb_    ((bf16_t*)(ws + WS_R2 + 80 * MiB))
#define P_vtb    ((bf16_t*)(ws + WS_R2 + 128 * MiB))
#define P_qmb    ((bf16_t*)(ws + WS_R2 + 176 * MiB))
#define P_gates  ((bf16_t*)(ws + WS_R2))
#define P_h      ((bf16_t*)(ws + WS_R3))
#define P_merged ((bf16_t*)(ws + WS_R3))
#define P_pooled ((bf16_t*)(ws + WS_R5))
#define P_mo     ((bf16_t*)(ws + WS_R5 + 32 * MiB))
#define P_pmb    ((bf16_t*)(ws + WS_R5 + 64 * MiB))
#define P_cs     ((float*)(ws + WS_COS))
#define P_sn     ((float*)(ws + WS_SIN))
#define P_memn   ((bf16_t*)(ws + WS_MEMN))
#define P_kmk    ((bf16_t*)(ws + WS_KVMK))
#define P_vmt    ((bf16_t*)(ws + WS_VMT))
#define P_lse    ((float*)(ws + WS_LSE))
#define P_x1b    ((bf16_t*)ARG(out))
#define P_x2b    ((bf16_t*)ARG(out) + (size_t)S * D)
#define P_h8     ((unsigned char*)ARG(out) + 64 * MiB)
#define P_ao8    ((unsigned char*)ARG(out) + 96 * MiB)
#define P_mo8    ((unsigned char*)ARG(out) + 104 * MiB)
#define P_Wupa8  ((unsigned char*)ARG(out) + 120 * MiB)
#define P_Wupm8  ((unsigned char*)ARG(out) + 121 * MiB)
#define P_Wg8    ((unsigned char*)(ws + WS_WG8))
#define P_W8b    ((unsigned char*)(ws + WS_W8B))
#define P_x3b    ((bf16_t*)(ws + WS_R3))
#define IN(p) (ARG(ph_lo) <= (p) && (p) < ARG(ph_hi))
#define PHASE_REP(p) for (int rep_ = 0; rep_ < ((p) == PROBE_PH ? 2 : 1); ++rep_)
#define REPSYNC do { if (rep_ > 0) xcd_barrier(xbar, wave == 0 && lane_id() == 0); } while (0)
#define SEAM(p) do { if (ARG(ph_lo) <= (p) && (p) + 1 < ARG(ph_hi)) { xcd_barrier(xbar, wave == 0 && lane_id() == 0); } } while (0)

    if (IN(0)) PHASE_REP(0) { REPSYNC;
        int rot = 0;
        cvt_matrix(lds, ARG(f1g), D, FF, P_Wgu, 3, rot, bid, G, tid, wave, lane);
        cvt_matrix(lds, ARG(f1u), D, FF, P_Wgu, 4, rot, bid, G, tid, wave, lane);
        cvt_matrix(lds, ARG(f1d), FF, D, P_Wd, 1, rot, bid, G, tid, wave, lane);
        cvt_matrix(lds, ARG(win), D, INC, P_Win, 2, rot, bid, G, tid, wave, lane);
        cvt_matrix(lds, ARG(wkv), D, 2048, P_Wkv, 5, rot, bid, G, tid, wave, lane);
        cvt_matrix(lds, ARG(wupp), 1024, D, P_Wupp, 1, rot, bid, G, tid, wave, lane);
        cvt_matrix(lds, ARG(wupa), 512, D, P_Wupa, 1, rot, bid, G, tid, wave, lane);
        cvt_matrix(lds, ARG(wupm), 1024, D, P_Wupm, 1, rot, bid, G, tid, wave, lane);
        cvt_matrix(lds, ARG(wout), D, D, P_Wout, 1, rot, bid, G, tid, wave, lane);
        for (int gp = 0; gp < 4; ++gp) cvt_matrix(lds, ARG(poolw) + gp * 65536, 256, 256, P_Wpool + gp * 65536, 1, rot, bid, G, tid, wave, lane);
        for (int i = bid * 512 + tid; i < S * 64; i += G * 512) { const int s_ = i >> 6, f = i & 63;
            const float inv = powf(10000.0f, -(float)f / 64.0f); const float ang = (float)ARG(pos)[s_] * inv; float sv, cv; sincosf(ang, &sv, &cv); P_cs[i] = cv; P_sn[i] = sv; }
        rmsnorm_rows<true>(ARG(x), ARG(f1n), P_h, S, gw, nw, lane);
        rmsnorm_rows<true>(ARG(mem), ARG(memn), P_memn, NMEM, gw, nw, lane);
    }
    SEAM(0);
    if (IN(1)) PHASE_REP(1) { REPSYNC;
        Gemm g{P_h, P_Wgu, D, D, S, 2 * FF, D}; StaticOrder so; so.init(S, 2 * FF, G, bid);
        gemm_phase<EpiGU, 0>(lds, g, so, EpiGU{P_act}, wave);
    }
    SEAM(1);
    if (IN(2)) PHASE_REP(2) { REPSYNC;
        Gemm g{P_act, P_Wd, FF, FF, S, D, FF}; StaticOrder so; so.init(S, D, G, bid);
        gemm_phase<EpiResB<true>, 0>(lds, g, so, EpiResB<true>{ARG(x), P_x1b, 0.5f, 0}, wave);
    }
    SEAM(2);
    if (IN(3)) PHASE_REP(3) { REPSYNC;
        {
            const int t0 = bid * 512 + tid, ts = G * 512;
            cvt_bf16_fp8(P_Win + (size_t)6656 * D, P_Wg8, 6144 * D / 8, t0, ts);
            cvt_bf16_fp8(P_Win + (size_t)1024 * D, P_W8b, 5632 * D / 8, t0, ts);
            cvt_bf16_fp8(P_Wupa, P_Wupa8, 512 * D / 8, t0, ts);
            cvt_bf16_fp8(P_Wupm, P_Wupm8, 1024 * D / 8, t0, ts);
        }
        rmsnorm_rows_b<true>(P_x1b, ARG(mixn), P_h, S, gw, nw, lane, P_h8);
    }
    SEAM(3);
    if (IN(4)) PHASE_REP(4) { REPSYNC;
        { Gemm g{P_h, P_Win, D, D, S, 1024, D}; StaticOrder so; so.init(S, 1024, G, bid);
          gemm_phase<EpiProj, 0>(lds, g, so, EpiProj{P_ub, P_qb_, P_kb_, P_qmb, P_cs, P_sn, 0.f, 0.f, 0.f, 0}, wave); }
        { Gemm g{(const bf16_t*)P_h8, (const bf16_t*)P_W8b, D / 2, D / 2, S, 4096, D / 2}; StaticOrder so; so.init(S, 4096, G, bid);
          gemm_phase<EpiProj, 0, true>(lds, g, so, EpiProj{P_ub, P_qb_, P_kb_, P_qmb, P_cs, P_sn, LOG2E * 0.08838834764831845f / 64.0f, LOG2E * 0.0625f / 64.0f, 1.0f / 64.0f, 4}, wave); }
        const int G2 = G / 2; const bf16_t* const wv8 = (const bf16_t*)(P_W8b + (size_t)4096 * D);
        if (bid < G2) { Gemm g{wv8, (const bf16_t*)P_h8, D / 2, D / 2, 512, S, D / 2}; StaticOrder so; so.init(512, S, G2, bid); gemm_phase<EpiVt<1>, 1, true>(lds, g, so, EpiVt<1>{P_vtb, 1.0f / 64.0f, 0}, wave); }
        else { Gemm g{wv8 + (size_t)512 * (D / 2), (const bf16_t*)P_h8, D / 2, D / 2, 512, S, D / 2}; StaticOrder so; so.init(512, S, G - G2, bid - G2); gemm_phase<EpiVt<4>, 4, true>(lds, g, so, EpiVt<4>{P_vtb + (size_t)4 * S * 128, 1.0f / 64.0f, 0}, wave); }
        if (bid < G2) { Gemm g{wv8 + (size_t)1024 * (D / 2), (const bf16_t*)P_h8, D / 2, D / 2, 512, S, D / 2}; StaticOrder so; so.init(512, S, G2, bid); gemm_phase<EpiVt<16>, 16, true>(lds, g, so, EpiVt<16>{P_vtb + (size_t)8 * S * 128, 1.0f / 64.0f, 0}, wave); }
        else if (bid - G2 < 4) { Gemm g{P_memn, P_Wkv, D, D, NMEM, 1024, D}; StaticOrder so; so.init(NMEM, 1024, 4, bid - G2); gemm_phase<EpiKvmK, 0>(lds, g, so, EpiKvmK{P_kmk}, wave); }
        else if (bid - G2 < 8) { Gemm g{P_Wkv + (size_t)1024 * D, P_memn, D, D, 1024, NMEM, D}; StaticOrder so; so.init(1024, NMEM, 4, bid - G2 - 4); gemm_phase<EpiKvmVt, 1>(lds, g, so, EpiKvmVt{P_vmt}, wave); }
    }
    SEAM(4);
    if (IN(5)) PHASE_REP(5) { REPSYNC;
        for (int T = gw; T < 12288 * DBG_ATT; T += nw) attn_tile(P_qb_, P_kb_, P_vtb, P_og, P_lse, T, lane);
        for (int un = bid; un < 512; un += G) mem_unit(lds, P_qmb, P_kmk, P_vmt, P_mo, P_mo8, un, tid, wave, lane);
        {
            const int gp = wave >> 1;
            for (int c0 = bid; c0 < S / 64; c0 += G) {
                if (gp == 0) pool_chunk<1>(P_ub, P_pooled, c0 * 64, 2 * tid);
                else if (gp == 1) pool_chunk<2>(P_ub, P_pooled, c0 * 64, 2 * tid);
                else if (gp == 2) pool_chunk<4>(P_ub, P_pooled, c0 * 64, 2 * tid);
                else pool_chunk<8>(P_ub, P_pooled, c0 * 64, 2 * tid);
            }
        }
    }
    SEAM(5);
    if (IN(6)) PHASE_REP(6) { REPSYNC;
        for (int i0 = bid * 512 + tid; i0 < S * 64; i0 += 4 * G * 512) {
            float l_[4][3]; u32x4 x_[4][3];
#pragma unroll
            for (int j = 0; j < 4; ++j) { const int ij = i0 + j * G * 512, i = ij < S * 64 ? ij : i0; const int t = i >> 6, col = (i & 63) * 8, hg = col >> 7;
#pragma unroll
                for (int g_ = 0; g_ < 3; ++g_) { l_[j][g_] = P_lse[((size_t)g_ * S + t) * 4 + hg]; x_[j][g_] = *(const u32x4*)(P_og + ((size_t)g_ * S + t) * 512 + col); } }
#pragma unroll
            for (int j = 0; j < 4; ++j) { const int i = i0 + j * G * 512; const int t = i >> 6, col = (i & 63) * 8;
                const float l0_ = l_[j][0], l1_ = l_[j][1], l2_ = l_[j][2]; const u32x4 x0 = x_[j][0], x1 = x_[j][1], x2 = x_[j][2];
                const float mm = fmaxf(l0_, fmaxf(l1_, l2_)); float w0 = fast_exp2(l0_ - mm), w1 = fast_exp2(l1_ - mm), w2 = fast_exp2(l2_ - mm); const float iw = 1.0f / (w0 + w1 + w2); w0 *= iw; w1 *= iw; w2 *= iw;
                u32x4 o_;
                o_.x = cvt_pk_bf16(w0 * bf_lo(x0.x) + w1 * bf_lo(x1.x) + w2 * bf_lo(x2.x), w0 * bf_hi(x0.x) + w1 * bf_hi(x1.x) + w2 * bf_hi(x2.x));
                o_.y = cvt_pk_bf16(w0 * bf_lo(x0.y) + w1 * bf_lo(x1.y) + w2 * bf_lo(x2.y), w0 * bf_hi(x0.y) + w1 * bf_hi(x1.y) + w2 * bf_hi(x2.y));
                o_.z = cvt_pk_bf16(w0 * bf_lo(x0.z) + w1 * bf_lo(x1.z) + w2 * bf_lo(x2.z), w0 * bf_hi(x0.z) + w1 * bf_hi(x1.z) + w2 * bf_hi(x2.z));
                o_.w = cvt_pk_bf16(w0 * bf_lo(x0.w) + w1 * bf_lo(x1.w) + w2 * bf_lo(x2.w), w0 * bf_hi(x0.w) + w1 * bf_hi(x1.w) + w2 * bf_hi(x2.w));
                const f32x4 a0 = (f32x4){bf_lo(o_.x), bf_hi(o_.x), bf_lo(o_.y), bf_hi(o_.y)} * 16.0f, a1 = (f32x4){bf_lo(o_.z), bf_hi(o_.z), bf_lo(o_.w), bf_hi(o_.w)} * 16.0f;
                u32x2 q; q.x = pk_fp8x4(a0); q.y = pk_fp8x4(a1); if (i < S * 64) *(u32x2*)(P_ao8 + (size_t)t * 512 + col) = q; } }
        { const int G4 = G / 4, gp = bid / G4 < 3 ? bid / G4 : 3, c = bid - gp * G4, gn = gp < 3 ? G4 : G - 3 * G4;
          Gemm g{P_pooled + gp * 256, P_Wpool + gp * 65536, 1024, 256, S, 256, 256}; StaticOrder so; so.init(S, 256, gn, c);
          gemm_phase<EpiPm, 0>(lds, g, so, EpiPm{P_pmb, ARG(pools), gp}, wave); }
        { Gemm g{(const bf16_t*)P_h8, (const bf16_t*)P_Wg8, D / 2, D / 2, S, 3 * D, D / 2}; StaticOrder so; so.init(S, 3 * D, G, bid);
          gemm_phase<EpiGate, 0, true>(lds, g, so, EpiGate{P_gates, ARG(bgate), 1.0f / 64.0f, 0}, wave); }
    }
    SEAM(6);
    if (IN(7)) PHASE_REP(7) { REPSYNC;
        StaticOrder so; so.init(S, D, G, bid);
        { Gemm g{P_pmb, P_Wupp, 1024, 1024, S, D, 1024}; gemm_phase<EpiUp, 0>(lds, g, so, EpiUp{P_merged, P_gates, 0, 1.0f}, wave); }
        { Gemm g{(const bf16_t*)P_ao8, (const bf16_t*)P_Wupa8, 256, 256, S, D, 256}; gemm_phase<EpiUp, 0, true>(lds, g, so, EpiUp{P_merged, P_gates, 1, 1.0f / 1024.0f}, wave); }
        { Gemm g{(const bf16_t*)P_mo8, (const bf16_t*)P_Wupm8, 512, 512, S, D, 512}; gemm_phase<EpiUp, 0, true>(lds, g, so, EpiUp{P_merged, P_gates, 2, 1.0f / 1024.0f}, wave); }
    }
    SEAM(7);
    if (IN(8)) PHASE_REP(8) { REPSYNC;
        Gemm g{P_merged, P_Wout, D, D, S, D, D}; StaticOrder so; so.init(S, D, G, bid);
        gemm_phase<EpiResB<false>, 0>(lds, g, so, EpiResB<false>{P_x1b, P_x2b, 1.0f, 0}, wave);
    }
    SEAM(8);
    if (IN(9)) PHASE_REP(9) { REPSYNC;
        int rot = 0;
        cvt_matrix(lds, ARG(f2g), D, FF, P_Wgu, 3, rot, bid, G, tid, wave, lane);
        cvt_matrix(lds, ARG(f2u), D, FF, P_Wgu, 4, rot, bid, G, tid, wave, lane);
        cvt_matrix(lds, ARG(f2d), FF, D, P_Wd, 1, rot, bid, G, tid, wave, lane);
        rmsnorm_rows_b<true>(P_x2b, ARG(f2n), P_h, S, gw, nw, lane);
    }
    SEAM(9);
    if (IN(10)) PHASE_REP(10) { REPSYNC;
        Gemm g{P_h, P_Wgu, D, D, S, 2 * FF, D}; StaticOrder so; so.init(S, 2 * FF, G, bid);
        gemm_phase<EpiGU, 0>(lds, g, so, EpiGU{P_act}, wave);
    }
    SEAM(10);
    if (IN(11)) PHASE_REP(11) { REPSYNC;
        Gemm g{P_act, P_Wd, FF, FF, S, D, FF}; StaticOrder so; so.init(S, D, G, bid);
        gemm_phase<EpiResB<false>, 0>(lds, g, so, EpiResB<false>{P_x2b, P_x3b, 0.5f, 0}, wave);
    }
    SEAM(11);
    if (IN(12)) rmsnorm_rows_b<false>(P_x3b, ARG(finn), ARG(out), S, gw, nw, lane);
#undef IN
#undef SEAM
#undef lane
#undef tid
}


#ifndef DBG_UPTO
#define DBG_UPTO 12
#endif
#ifndef DBG_FOLD
#define DBG_FOLD 0
#endif
__global__ void dbg_fold(const unsigned short* w, float* out, size_t nws, int n) {
    for (int i = blockIdx.x * blockDim.x + threadIdx.x; i < n; i += gridDim.x * blockDim.x) {
        unsigned acc_ = 0; for (size_t j = (size_t)i; j < nws; j += (size_t)n) acc_ += w[j];
        out[i] = (float)acc_;
    }
}
#ifndef N_LAUNCH_MODE
#define N_LAUNCH_MODE 1
#endif

extern "C" void kernel_launch(void* const* d_in, const int* in_sizes, int n_in, void* d_out, int out_size, void* d_ws, size_t ws_size, hipStream_t stream) {
    static int grid = 0;
    if (grid == 0) {
        if (n_in != 23 || ws_size < WS_END) { fprintf(stderr, "kernel_launch: unexpected n_in %d or ws_size %zu (< %zu)\n", n_in, ws_size, (size_t)WS_END); grid = -1; return; }
        int dev = 0, cus = 0, per_cu = 0;
        hipGetDevice(&dev); hipDeviceGetAttribute(&cus, hipDeviceAttributeMultiprocessorCount, dev);
        if (hipFuncSetAttribute((const void*)fwd_kernel, hipFuncAttributeMaxDynamicSharedMemorySize, LDS_TOTAL) != hipSuccess) { fprintf(stderr, "kernel_launch: hipFuncSetAttribute failed\n"); grid = -1; return; }
        hipOccupancyMaxActiveBlocksPerMultiprocessor(&per_cu, (const void*)fwd_kernel, 512, LDS_TOTAL);
        if (per_cu < 1) { fprintf(stderr, "kernel_launch: occupancy query says %d\n", per_cu); per_cu = 1; }
        (void)hipGetLastError();
        grid = cus * 1;
    }
    if (grid < 0) return;
    if (hipMemsetAsync((char*)d_ws + WS_BAR, 0, XCD_BAR_WORDS * 4, stream) != hipSuccess) { fprintf(stderr, "kernel_launch: memset failed\n"); return; }
    Args a{};
    a.x = (const float*)d_in[0]; a.mem = (const float*)d_in[1]; a.pos = (const int*)d_in[2];
    a.f1n = (const float*)d_in[3]; a.f1g = (const float*)d_in[4]; a.f1u = (const float*)d_in[5]; a.f1d = (const float*)d_in[6];
    a.mixn = (const float*)d_in[7]; a.win = (const float*)d_in[8]; a.bgate = (const float*)d_in[9]; a.poolw = (const float*)d_in[10]; a.pools = (const float*)d_in[11];
    a.memn = (const float*)d_in[12]; a.wkv = (const float*)d_in[13]; a.wupp = (const float*)d_in[14]; a.wupa = (const float*)d_in[15]; a.wupm = (const float*)d_in[16]; a.wout = (const float*)d_in[17];
    a.f2n = (const float*)d_in[18]; a.f2g = (const float*)d_in[19]; a.f2u = (const float*)d_in[20]; a.f2d = (const float*)d_in[21]; a.finn = (const float*)d_in[22];
    a.out = (float*)d_out; a.ws = (unsigned char*)d_ws;
#if N_LAUNCH_MODE == 1
    a.ph_lo = 0; a.ph_hi = NPH + 1;
    void* args[] = {&a};
    hipError_t e = hipLaunchCooperativeKernel((const void*)fwd_kernel, dim3(grid), dim3(512), args, LDS_TOTAL, stream);
    if (e != hipSuccess) fprintf(stderr, "cooperative launch failed: %s (grid %d)\n", hipGetErrorString(e), grid);
#else
    for (int p = 0; p <= NPH && p <= DBG_UPTO; ++p) { a.ph_lo = p; a.ph_hi = p + 1; hipLaunchKernelGGL(fwd_kernel, dim3(grid), dim3(512), LDS_TOTAL, stream, a); }
#if DBG_FOLD
    hipLaunchKernelGGL(dbg_fold, dim3(2048), dim3(256), 0, stream, (const unsigned short*)d_ws, (float*)d_out, (size_t)(WS_END / 2), out_size);
#endif
#endif
}
```

```cpp
#include <hip/hip_runtime.h>
#include <hip/hip_cooperative_groups.h>
#include <cstdio>
namespace cg = cooperative_groups;

#define LAS __attribute__((address_space(3)))
typedef unsigned short bf16_t;
typedef short bf16x8 __attribute__((ext_vector_type(8)));
typedef float f32x4 __attribute__((ext_vector_type(4)));
typedef unsigned u32x4 __attribute__((ext_vector_type(4)));
typedef unsigned u32x2 __attribute__((ext_vector_type(2)));

constexpr int S = 16384, D = 2048, FF = 5632, NMEM = 256;
constexpr int INC = 12800;
#define DBG_ATT 1
#ifndef PROBE_PH
#define PROBE_PH 99
#endif
constexpr float EPS = 1e-6f;
constexpr float LOG2E = 1.4426950408889634f;
constexpr size_t MiB = 1ull << 20;
constexpr size_t WS_WA   = 0;
constexpr size_t WS_WIN  = WS_WA + 66 * MiB;
constexpr size_t WS_WKV  = WS_WIN + 50 * MiB;
constexpr size_t WS_WUPP = WS_WKV + 8 * MiB;
constexpr size_t WS_WUPA = WS_WUPP + 4 * MiB;
constexpr size_t WS_WUPM = WS_WUPA + 2 * MiB;
constexpr size_t WS_WOUT = WS_WUPM + 4 * MiB;
constexpr size_t WS_WPOOL = WS_WOUT + 8 * MiB;
constexpr size_t WS_R2   = WS_WPOOL + 1 * MiB;
constexpr size_t WS_R3   = WS_R2 + 208 * MiB;
constexpr size_t WS_R5   = WS_R3 + 64 * MiB;
constexpr size_t WS_COS  = WS_R5 + 96 * MiB;
constexpr size_t WS_SIN  = WS_COS + 4 * MiB;
constexpr size_t WS_MEMN = WS_SIN + 4 * MiB;
constexpr size_t WS_KVMK = WS_MEMN + 1 * MiB;
constexpr size_t WS_VMT  = WS_KVMK + MiB / 2;
constexpr size_t WS_LSE  = WS_VMT + MiB / 2;
constexpr size_t WS_BAR  = WS_LSE + 1 * MiB;
constexpr size_t WS_WG8  = WS_BAR + 1 * MiB;
constexpr size_t WS_W8B  = WS_WG8 + 12 * MiB;
constexpr size_t WS_END  = WS_W8B + 11 * MiB;

typedef float f32x2 __attribute__((ext_vector_type(2)));
typedef __bf16 bf16x2v __attribute__((ext_vector_type(2)));
__device__ __forceinline__ unsigned cvt_pk_bf16(float lo, float hi) { const f32x2 v = {lo, hi}; const bf16x2v b = __builtin_convertvector(v, bf16x2v); return __builtin_bit_cast(unsigned, b); }
__device__ __forceinline__ float bf_lo(unsigned w) { return __uint_as_float(w << 16); }
__device__ __forceinline__ float bf_hi(unsigned w) { return __uint_as_float(w & 0xffff0000u); }
__device__ __forceinline__ unsigned pk_fp8x4(f32x4 v) { unsigned w = __builtin_amdgcn_cvt_pk_fp8_f32(v[0], v[1], 0, false); return __builtin_amdgcn_cvt_pk_fp8_f32(v[2], v[3], w, true); }
__device__ __forceinline__ int lane_id() { return (int)__builtin_amdgcn_mbcnt_hi(~0u, __builtin_amdgcn_mbcnt_lo(~0u, 0u)); }
__device__ __forceinline__ float fast_exp2(float x) { return __builtin_amdgcn_exp2f(x); }
__device__ __forceinline__ float fast_rcp(float x) { return __builtin_amdgcn_rcpf(x); }

constexpr int BM = 256, BK = 64, HALF = 128, HTB = HALF * BK * 2, STAGE_BYTES = 8 * HTB, NXCD = 8, WGM = 4;
__device__ __forceinline__ int lds_byte(int r, int c) { const int st = (r >> 4) * 2 + (c >> 5), rr = r & 15, cc = c & 31, ob = rr * 64 + cc * 2; return st * 1024 + (ob ^ (((ob >> 9) & 1) << 5)); }
__device__ __forceinline__ void stage_rc(int b, int& R, int& C) { const int st = b / 1024, sb = b % 1024, swz = sb ^ (((sb >> 9) & 1) << 5); R = (st >> 1) * 16 + swz / 64; C = (st & 1) * 32 + (swz % 64) / 2; }
__device__ __forceinline__ int perm32(int rho) { const int n = rho >> 4, i = rho & 15; return 8 * (i >> 2) + 4 * n + (i & 3); }
__host__ __device__ __forceinline__ int permb(int c) { return (c & ~31) + 16 * ((c >> 2) & 1) + 4 * ((c & 31) >> 3) + (c & 3); }

struct Unit { int pm, pn; };
struct Gemm { const bf16_t* A; const bf16_t* Bt; int lda, ldb, M, N, K; };
struct StaticOrder {
    int nM, nN, nwg, G, c;
    __device__ void init(int M, int N, int G_, int c_) { nM = M / BM; nN = N / BM; nwg = nM * nN; G = G_; c = c_; }
    __device__ bool next(int i, Unit& u) const {
        const long L = (long)i * G + c; if (L >= nwg) return false;
        int wgid = (int)L; { const int q = nwg / NXCD, r = nwg % NXCD, xcd = wgid % NXCD, off = wgid / NXCD; wgid = (xcd < r ? xcd * (q + 1) : r * (q + 1) + (xcd - r) * q) + off; }
        const int nig = WGM * nN, gid = wgid / nig, fm = gid * WGM, gsz = (nM - fm) < WGM ? (nM - fm) : WGM;
        u.pm = fm + ((wgid % nig) % gsz); u.pn = (wgid % nig) / gsz; return true;
    }
};

template <int BP> __device__ __forceinline__ int bperm_row(int R) {
    if (BP == 0) return R;
    const int v = (R & ~31) + perm32(R & 31);
    if (BP == 1) return v;
    constexpr int per = 256 / (BP > 1 ? BP : 2);
    const int r = v / per, l = v % per;
    return l * BP + r;
}

typedef int i32x4 __attribute__((ext_vector_type(4)));
typedef int i32x8 __attribute__((ext_vector_type(8)));
__device__ __forceinline__ i32x8 cat8(bf16x8 a, bf16x8 b) { return __builtin_shufflevector(__builtin_bit_cast(i32x4, a), __builtin_bit_cast(i32x4, b), 0, 1, 2, 3, 4, 5, 6, 7); }
__device__ __forceinline__ void mfma_fp8_inplace(f32x4& c, const i32x8 a, const i32x8 b) { asm volatile("v_mfma_f32_16x16x128_f8f6f4 %0, %1, %2, %0" : "+v"(c) : "v"(a), "v"(b)); }
template <class Epi, int BP, bool FP8 = false>
__device__ __forceinline__ void gemm_phase(LAS unsigned char* lds, const Gemm g, const StaticOrder& S_, const Epi& E, const int wid) {
    const int lane = lane_id(), tid = wid * 64 + lane, wr = wid >> 2, wc = wid & 3, fr = lane & 15, fq = lane >> 4;
    int K_ = g.K; asm volatile("" : "+s"(K_));
    const int K = K_, nt = K / BK;
    unsigned voffA, voffB;
    { int R, C; stage_rc(tid * 16, R, C); voffA = (unsigned)(R * g.lda + C) * 2u; voffB = (unsigned)(bperm_row<BP>(R) * g.ldb + C) * 2u; }
    const size_t d64A = (size_t)64 * g.lda * 2, d64B = (size_t)(BP <= 1 ? 64 : BP / 4) * g.ldb * 2;
    const size_t kstep = (size_t)(BK * 2);
    const size_t hstepA = (size_t)HALF * g.lda * 2;
    const size_t hstepB = (size_t)(BP <= 1 ? HALF : BP / 2) * g.ldb * 2;
    const size_t tstepA = (size_t)BM * g.lda * 2, tstepB = (size_t)BM * g.ldb * 2;
    const unsigned ldsw = (unsigned)wid * 1024u;
    const int aoff = lds_byte(wr * 64 + fr, FP8 ? fq * 16 : fq * 8), boff = lds_byte(wc * 32 + fr, FP8 ? fq * 16 : fq * 8);
    constexpr int KOFF = FP8 ? 16 : 1024;
#define PG8_SA(b, h) (((b) * 2 + (h)) * HTB)
#define PG8_SB(b, h) ((4 + (b) * 2 + (h)) * HTB)
#define PG8_STAGE(bufoff, gbase, voff) do { _Pragma("unroll") for (int _i = 0; _i < 2; ++_i) \
        __builtin_amdgcn_global_load_lds((const unsigned*)((const char*)(gbase) + (size_t)_i * (&(voff) == &voffA ? d64A : d64B) + (voff)), (LAS unsigned*)(lds + (bufoff) + ldsw + _i * 8192), 16, 0, 0); } while (0)
#define PG8_LDA(dst, b, h) do { if constexpr (FP8) { _Pragma("unroll") for (int m = 0; m < 4; ++m) dst##8[m] = cat8(*(const LAS bf16x8*)(lds + PG8_SA(b, h) + aoff + m * 2048), *(const LAS bf16x8*)(lds + PG8_SA(b, h) + aoff + m * 2048 + 16)); } \
        else { _Pragma("unroll") for (int m = 0; m < 4; ++m) _Pragma("unroll") for (int k = 0; k < 2; ++k) dst[m][k] = *(const LAS bf16x8*)(lds + PG8_SA(b, h) + aoff + m * 2048 + k * KOFF); } } while (0)
#define PG8_LDB(dst, b, h) do { if constexpr (FP8) { _Pragma("unroll") for (int n = 0; n < 2; ++n) dst##8[n] = cat8(*(const LAS bf16x8*)(lds + PG8_SB(b, h) + boff + n * 2048), *(const LAS bf16x8*)(lds + PG8_SB(b, h) + boff + n * 2048 + 16)); } \
        else { _Pragma("unroll") for (int n = 0; n < 2; ++n) _Pragma("unroll") for (int k = 0; k < 2; ++k) dst[n][k] = *(const LAS bf16x8*)(lds + PG8_SB(b, h) + boff + n * 2048 + k * KOFF); } } while (0)
#define PG8_MMA(ai, bj, At, Bt) do { __builtin_amdgcn_s_setprio(1); \
        if constexpr (FP8) { _Pragma("unroll") for (int m = 0; m < 4; ++m) _Pragma("unroll") for (int n = 0; n < 2; ++n) \
            mfma_fp8_inplace(acc[ai][bj][m][n], Bt##8[n], At##8[m]); } \
        else { _Pragma("unroll") for (int m = 0; m < 4; ++m) _Pragma("unroll") for (int n = 0; n < 2; ++n) _Pragma("unroll") for (int k = 0; k < 2; ++k) \
            acc[ai][bj][m][n] = __builtin_amdgcn_mfma_f32_16x16x32_bf16(Bt[n][k], At[m][k], acc[ai][bj][m][n], 0, 0, 0); } \
        __builtin_amdgcn_s_setprio(0); } while (0)
#define PG8_WAIT_V(n) asm volatile("s_waitcnt vmcnt(" #n ")" ::: "memory")
#define PG8_WAIT_L(n) asm volatile("s_waitcnt lgkmcnt(" #n ")" ::: "memory")
#define PG8_BAR __builtin_amdgcn_s_barrier()
#define PG8_SCHED __builtin_amdgcn_sched_barrier(0)
    Unit cur, nxt; int ui = 0;
    if (!S_.next(0, cur)) return;
    f32x4 acc[2][2][4][2];
#pragma unroll
    for (int a = 0; a < 2; ++a)
#pragma unroll
        for (int b = 0; b < 2; ++b)
#pragma unroll
            for (int m = 0; m < 4; ++m)
#pragma unroll
                for (int n = 0; n < 2; ++n) acc[a][b][m][n] = (f32x4){0.f, 0.f, 0.f, 0.f};
    bf16x8 At[4][2], B0[2][2], B1[2][2]; i32x8 At8[4], B08[2], B18[2];
    const char* cA = (const char*)g.A + (size_t)cur.pm * tstepA; const char* cB = (const char*)g.Bt + (size_t)cur.pn * tstepB;
    PG8_STAGE(PG8_SB(0, 0), cB, voffB); PG8_STAGE(PG8_SA(0, 0), cA, voffA); PG8_STAGE(PG8_SB(0, 1), cB + hstepB, voffB); PG8_STAGE(PG8_SA(0, 1), cA + hstepA, voffA);
    if (wr == 1) PG8_BAR;
    PG8_WAIT_V(4); PG8_BAR;
    PG8_STAGE(PG8_SB(1, 0), cB + kstep, voffB); PG8_STAGE(PG8_SA(1, 0), cA + kstep, voffA); PG8_STAGE(PG8_SB(1, 1), cB + hstepB + kstep, voffB);
    PG8_WAIT_V(6); PG8_BAR;
    for (;;) {
        const bool has_next = S_.next(ui + 1, nxt);
        const char* nA = has_next ? (const char*)g.A + (size_t)nxt.pm * tstepA : cA; const char* nB = has_next ? (const char*)g.Bt + (size_t)nxt.pn * tstepB : cB;
        for (int t = 0; t < nt; t += 2) {
            const bool last = (t == nt - 2);
            const char* a1 = cA + (size_t)(t + 1) * kstep;
            const char* a2 = last ? nA : cA + (size_t)(t + 2) * kstep; const char* b2 = last ? nB : cB + (size_t)(t + 2) * kstep;
            const char* a3 = a2 + kstep; const char* b3 = b2 + kstep;
            PG8_LDB(B0, 0, 0); PG8_SCHED; PG8_LDA(At, 0, 0); PG8_STAGE(PG8_SA(1, 1), a1 + hstepA, voffA);
            PG8_WAIT_L(8); PG8_BAR; PG8_WAIT_L(0); PG8_MMA(0, 0, At, B0); PG8_BAR; PG8_SCHED;
            PG8_LDB(B1, 0, 1); PG8_STAGE(PG8_SB(0, 0), b2, voffB);
            PG8_BAR; PG8_WAIT_L(0); PG8_MMA(0, 1, At, B1); PG8_BAR;
            PG8_LDA(At, 0, 1); PG8_STAGE(PG8_SA(0, 0), a2, voffA);
            PG8_BAR; PG8_WAIT_L(0); PG8_MMA(1, 0, At, B0); PG8_BAR; PG8_SCHED;
            PG8_STAGE(PG8_SB(0, 1), b2 + hstepB, voffB);
            PG8_WAIT_V(6); PG8_BAR; PG8_MMA(1, 1, At, B1); PG8_BAR;
            PG8_LDB(B0, 1, 0); PG8_SCHED; PG8_LDA(At, 1, 0); PG8_STAGE(PG8_SA(0, 1), a2 + hstepA, voffA);
            PG8_WAIT_L(8); PG8_BAR; PG8_WAIT_L(0); PG8_MMA(0, 0, At, B0); PG8_BAR; PG8_SCHED;
            PG8_LDB(B1, 1, 1); PG8_STAGE(PG8_SB(1, 0), b3, voffB);
            PG8_BAR; PG8_WAIT_L(0); PG8_MMA(0, 1, At, B1); PG8_BAR;
            PG8_LDA(At, 1, 1); PG8_STAGE(PG8_SA(1, 0), a3, voffA);
            PG8_BAR; PG8_WAIT_L(0); PG8_MMA(1, 0, At, B0); PG8_BAR; PG8_SCHED;
            PG8_STAGE(PG8_SB(1, 1), b3 + hstepB, voffB);
            PG8_WAIT_V(6); PG8_BAR; PG8_MMA(1, 1, At, B1); PG8_BAR;
        }
        if constexpr (FP8) asm volatile("s_nop 15\n\ts_nop 15" ::: "memory");
        { const int ln_ = __builtin_amdgcn_mbcnt_hi(~0u, __builtin_amdgcn_mbcnt_lo(~0u, 0u)); E(acc, cur, wr, wc, ln_ & 15, ln_ >> 4); }
        if (!has_next) break;
#pragma unroll
        for (int a = 0; a < 2; ++a)
#pragma unroll
            for (int b = 0; b < 2; ++b)
#pragma unroll
                for (int m = 0; m < 4; ++m)
#pragma unroll
                    for (int n = 0; n < 2; ++n) acc[a][b][m][n] = (f32x4){0.f, 0.f, 0.f, 0.f};
        cur = nxt; cA = nA; cB = nB; ++ui;
    }
    PG8_WAIT_V(0);
    if (wr == 0) PG8_BAR;
    PG8_BAR;
#undef PG8_SA
#undef PG8_SB
#undef PG8_STAGE
#undef PG8_LDA
#undef PG8_LDB
#undef PG8_MMA
#undef PG8_WAIT_V
#undef PG8_WAIT_L
#undef PG8_BAR
#undef PG8_SCHED
}

typedef f32x4 AccT[2][2][4][2];
__device__ __forceinline__ u32x4 pack8(f32x4 a, f32x4 b) { u32x4 w; w.x = cvt_pk_bf16(a[0], a[1]); w.y = cvt_pk_bf16(a[2], a[3]); w.z = cvt_pk_bf16(b[0], b[1]); w.w = cvt_pk_bf16(b[2], b[3]); return w; }
__device__ __forceinline__ u32x2 pack4(f32x4 a) { u32x2 w; w.x = cvt_pk_bf16(a[0], a[1]); w.y = cvt_pk_bf16(a[2], a[3]); return w; }

struct EpiGU { bf16_t* act;
    __device__ __forceinline__ void operator()(const AccT& acc, const Unit& u, int wr, int wc, int fr, int fq) const {
        const int row0 = u.pm * BM + wr * 64 + fr, col0 = u.pn * 128 + wc * 32 + 8 * fq;
#pragma unroll
        for (int ai = 0; ai < 2; ++ai)
#pragma unroll
            for (int m = 0; m < 4; ++m) { f32x4 v[2];
#pragma unroll
                for (int n = 0; n < 2; ++n) { const f32x4 gt = acc[ai][0][m][n], up = acc[ai][1][m][n];
#pragma unroll
                    for (int j = 0; j < 4; ++j) v[n][j] = gt[j] * fast_rcp(1.0f + fast_exp2(-gt[j] * LOG2E)) * up[j]; }
                *(u32x4*)(act + (size_t)(row0 + ai * HALF + m * 16) * FF + col0) = pack8(v[0], v[1]); }
    }
};
struct EpiRes { const float* xin; float* xout; float alpha;
    __device__ __forceinline__ void operator()(const AccT& acc, const Unit& u, int wr, int wc, int fr, int fq) const {
        const int row0 = u.pm * BM + wr * 64 + fr, col0 = u.pn * BM + wc * 32 + 4 * fq;
#pragma unroll
        for (int ai = 0; ai < 2; ++ai)
#pragma unroll
            for (int m = 0; m < 4; ++m) { const size_t off = (size_t)(row0 + ai * HALF + m * 16) * D + col0;
#pragma unroll
                for (int bj = 0; bj < 2; ++bj)
#pragma unroll
                    for (int n = 0; n < 2; ++n) { const f32x4 b = *(const f32x4*)(xin + off + bj * HALF + n * 16); *(f32x4*)(xout + off + bj * HALF + n * 16) = b + alpha * acc[ai][bj][m][n]; }
                asm volatile("" ::: "memory"); }
    }
};
template <bool XF32> struct EpiResB { const void* xin; bf16_t* xout; float alpha; int pad_;
    __device__ __forceinline__ void operator()(const AccT& acc, const Unit& u, int wr, int wc, int fr, int fq) const {
        const int row0 = u.pm * BM + wr * 64 + fr, col0 = u.pn * BM + wc * 32 + 8 * fq;
        const float al = alpha; const float* const xf = (const float*)xin; const bf16_t* const xb = (const bf16_t*)xin; bf16_t* const xo = xout;
#pragma unroll
        for (int ai = 0; ai < 2; ++ai) {
            f32x4 b0[4][2], b1[4][2];
#pragma unroll
            for (int m = 0; m < 4; ++m) { const size_t off = (size_t)(row0 + ai * HALF + m * 16) * D + col0;
#pragma unroll
                for (int bj = 0; bj < 2; ++bj) {
                    if (XF32) { b0[m][bj] = *(const f32x4*)(xf + off + bj * HALF); b1[m][bj] = *(const f32x4*)(xf + off + bj * HALF + 4); }
                    else { const u32x4 w = *(const u32x4*)(xb + off + bj * HALF); b0[m][bj] = (f32x4){bf_lo(w.x), bf_hi(w.x), bf_lo(w.y), bf_hi(w.y)}; b1[m][bj] = (f32x4){bf_lo(w.z), bf_hi(w.z), bf_lo(w.w), bf_hi(w.w)}; } } }
#pragma unroll
            for (int m = 0; m < 4; ++m) { const size_t off = (size_t)(row0 + ai * HALF + m * 16) * D + col0;
#pragma unroll
                for (int bj = 0; bj < 2; ++bj) *(u32x4*)(xo + off + bj * HALF) = pack8(b0[m][bj] + al * acc[ai][bj][m][0], b1[m][bj] + al * acc[ai][bj][m][1]); } }
    }
};
__device__ __forceinline__ void epi_plain(const AccT& acc, bf16_t* O, int ldc, int rowt, int colt, float scale, int wr, int wc, int fr, int fq) {
    const int row0 = rowt + wr * 64 + fr, col0 = colt + wc * 32 + 8 * fq;
#pragma unroll
    for (int ai = 0; ai < 2; ++ai)
#pragma unroll
        for (int m = 0; m < 4; ++m) { bf16_t* rowp = O + (size_t)(row0 + ai * HALF + m * 16) * ldc + col0;
#pragma unroll
            for (int bj = 0; bj < 2; ++bj) *(u32x4*)(rowp + bj * HALF) = pack8(acc[ai][bj][m][0] * scale, acc[ai][bj][m][1] * scale); }
}
struct EpiProj { bf16_t *u, *q, *k, *qm; const float* cs; const float* sn; float qscale, qmscale, kscale; int pn_off;
    __device__ __forceinline__ void operator()(const AccT& acc, const Unit& un, int wr, int wc, int fr, int fq) const {
        const int pn = un.pn + pn_off;
        if (pn < 4) { epi_plain(acc, u, 1024, un.pm * BM, pn * BM, 1.0f, wr, wc, fr, fq); return; }
        if (pn >= 16) { epi_plain(acc, qm, 1024, un.pm * BM, (pn - 16) * BM, qmscale, wr, wc, fr, fq); return; }
        const bool isq = pn < 10; bf16_t* base = isq ? q : k; const int colt = (pn - (isq ? 4 : 10)) * BM; const float sc = isq ? qscale : kscale;
        const int row0 = un.pm * BM + wr * 64 + fr, d0 = 16 * wc + 4 * fq;
#pragma unroll
        for (int ai = 0; ai < 2; ++ai) { f32x4 cc[4], ss[4];
#pragma unroll
            for (int m = 0; m < 4; ++m) { const int row = row0 + ai * HALF + m * 16; cc[m] = *(const f32x4*)(cs + (size_t)row * 64 + d0); ss[m] = *(const f32x4*)(sn + (size_t)row * 64 + d0); }
#pragma unroll
            for (int m = 0; m < 4; ++m) { const int row = row0 + ai * HALF + m * 16;
                const f32x4 c = cc[m] * sc, s = ss[m] * sc;
#pragma unroll
                for (int bj = 0; bj < 2; ++bj) { const f32x4 t1 = acc[ai][bj][m][0], t2 = acc[ai][bj][m][1];
                    bf16_t* p = base + (size_t)row * 1536 + colt + bj * HALF + d0;
                    *(u32x2*)p = pack4(t1 * c - t2 * s); *(u32x2*)(p + 64) = pack4(t2 * c + t1 * s); } } }
    }
};
template <int DIL> struct EpiVt { bf16_t* vt; float sc; int pad_;
    __device__ __forceinline__ void operator()(const AccT& acc, const Unit& u, int wr, int wc, int fr, int fq) const {
        constexpr int per = 256 / DIL, L8 = S / DIL / 8;
#pragma unroll
        for (int bj = 0; bj < 2; ++bj) { const int v0 = bj * HALF + wc * 32 + 8 * fq, r = v0 / per, l = per * u.pn + (v0 % per);
#pragma unroll
            for (int ai = 0; ai < 2; ++ai)
#pragma unroll
                for (int m = 0; m < 4; ++m) { const int grow = u.pm * BM + ai * HALF + wr * 64 + m * 16 + fr, hg = grow >> 7, dim = grow & 127;
                    *(u32x4*)(vt + ((((size_t)hg * DIL + r) * L8 + (l >> 3)) * 128 + dim) * 8) = pack8(acc[ai][bj][m][0] * sc, acc[ai][bj][m][1] * sc); } }
    }
};
struct EpiGate { bf16_t* gates; const float* bias; float ascale; int pad_;
    __device__ __forceinline__ void operator()(const AccT& acc, const Unit& u, int wr, int wc, int fr, int fq) const {
        const int row0 = u.pm * BM + wr * 64 + fr, col0 = u.pn * BM + wc * 32 + 8 * fq;
#pragma unroll
        for (int bj = 0; bj < 2; ++bj) { const f32x4 b0 = *(const f32x4*)(bias + col0 + bj * HALF), b1 = *(const f32x4*)(bias + col0 + bj * HALF + 4);
#pragma unroll
            for (int ai = 0; ai < 2; ++ai)
#pragma unroll
                for (int m = 0; m < 4; ++m) { f32x4 v0 = acc[ai][bj][m][0] * ascale + b0, v1 = acc[ai][bj][m][1] * ascale + b1;
#pragma unroll
                    for (int j = 0; j < 4; ++j) { v0[j] = fast_rcp(1.0f + fast_exp2(-v0[j] * LOG2E)); v1[j] = fast_rcp(1.0f + fast_exp2(-v1[j] * LOG2E)); }
                    *(u32x4*)(gates + (size_t)(row0 + ai * HALF + m * 16) * (3 * D) + col0 + bj * HALF) = pack8(v0, v1); } }
    }
};
struct EpiPm { bf16_t* pm; const float* scale; int g;
    __device__ __forceinline__ void operator()(const AccT& acc, const Unit& u, int wr, int wc, int fr, int fq) const {
        const int row0 = u.pm * BM + wr * 64 + fr, col0 = g * 256 + wc * 32 + 8 * fq;
#pragma unroll
        for (int bj = 0; bj < 2; ++bj) { const f32x4 s0 = *(const f32x4*)(scale + col0 + bj * HALF), s1 = *(const f32x4*)(scale + col0 + bj * HALF + 4);
#pragma unroll
            for (int ai = 0; ai < 2; ++ai)
#pragma unroll
                for (int m = 0; m < 4; ++m)
                    *(u32x4*)(pm + (size_t)(row0 + ai * HALF + m * 16) * 1024 + col0 + bj * HALF) = pack8(acc[ai][bj][m][0] * s0, acc[ai][bj][m][1] * s1); }
    }
};
struct EpiUp { bf16_t* merged; const bf16_t* gates; int b; float sc;
    __device__ __forceinline__ void operator()(const AccT& acc, const Unit& u, int wr, int wc, int fr, int fq) const {
        const int row0 = u.pm * BM + wr * 64 + fr, col0 = u.pn * BM + wc * 32 + 8 * fq;
        const int bb = b; const float s_ = sc; bf16_t* const mg = merged; const bf16_t* const gt = gates;
#pragma unroll
        for (int ai = 0; ai < 2; ++ai) {
            u32x4 gw[4][2], pw[4][2];
#pragma unroll
            for (int m = 0; m < 4; ++m) { const size_t row = (size_t)(row0 + ai * HALF + m * 16);
#pragma unroll
                for (int bj = 0; bj < 2; ++bj) { gw[m][bj] = *(const u32x4*)(gt + row * (3 * D) + bb * D + col0 + bj * HALF);
                    pw[m][bj] = bb > 0 ? *(const u32x4*)(mg + row * D + col0 + bj * HALF) : (u32x4){0u, 0u, 0u, 0u}; } }
#pragma unroll
            for (int m = 0; m < 4; ++m) { const size_t row = (size_t)(row0 + ai * HALF + m * 16);
#pragma unroll
                for (int bj = 0; bj < 2; ++bj) { const u32x4 g_ = gw[m][bj], p_ = pw[m][bj];
                    const f32x4 p0 = (f32x4){bf_lo(p_.x), bf_hi(p_.x), bf_lo(p_.y), bf_hi(p_.y)}, p1 = (f32x4){bf_lo(p_.z), bf_hi(p_.z), bf_lo(p_.w), bf_hi(p_.w)};
                    const f32x4 g0 = (f32x4){bf_lo(g_.x), bf_hi(g_.x), bf_lo(g_.y), bf_hi(g_.y)}, g1 = (f32x4){bf_lo(g_.z), bf_hi(g_.z), bf_lo(g_.w), bf_hi(g_.w)};
                    *(u32x4*)(mg + row * D + col0 + bj * HALF) = pack8(p0 + g0 * (acc[ai][bj][m][0] * s_), p1 + g1 * (acc[ai][bj][m][1] * s_)); } } }
    }
};
struct EpiKvmK { bf16_t* kk;
    __device__ __forceinline__ void operator()(const AccT& acc, const Unit& u, int wr, int wc, int fr, int fq) const { epi_plain(acc, kk, 1024, u.pm * BM, u.pn * BM, 1.0f, wr, wc, fr, fq); }
};
struct EpiKvmVt { bf16_t* vmt;
    __device__ __forceinline__ void operator()(const AccT& acc, const Unit& u, int wr, int wc, int fr, int fq) const {
#pragma unroll
        for (int bj = 0; bj < 2; ++bj) { const int tb = (bj * HALF + wc * 32 + 8 * fq) >> 3;
#pragma unroll
            for (int ai = 0; ai < 2; ++ai)
#pragma unroll
                for (int m = 0; m < 4; ++m) { const int grow = u.pm * BM + ai * HALF + wr * 64 + m * 16 + fr, hm = grow >> 8, dim = grow & 255;
                    *(u32x4*)(vmt + (((size_t)hm * 32 + tb) * 256 + dim) * 8) = pack8(acc[ai][bj][m][0], acc[ai][bj][m][1]); } }
    }
};

template <bool OUT_BF16>
__device__ __forceinline__ void rmsnorm_rows(const float* x, const float* g, void* out, int nrows, int wave0, int nwaves, int lane) {
    for (int r = wave0; r < nrows; r += 2 * nwaves) {
        const int r2 = r + nwaves; const bool two = r2 < nrows;
        const float* xr = x + (size_t)r * D; const float* xq = x + (size_t)(two ? r2 : r) * D; f32x4 v[8], w[8]; float ss = 0.f, st = 0.f;
#pragma unroll
        for (int c = 0; c < 8; ++c) v[c] = *(const f32x4*)(xr + (c * 64 + lane) * 4);
#pragma unroll
        for (int c = 0; c < 8; ++c) w[c] = *(const f32x4*)(xq + (c * 64 + lane) * 4);
#pragma unroll
        for (int c = 0; c < 8; ++c) { ss += v[c][0] * v[c][0] + v[c][1] * v[c][1] + v[c][2] * v[c][2] + v[c][3] * v[c][3]; st += w[c][0] * w[c][0] + w[c][1] * w[c][1] + w[c][2] * w[c][2] + w[c][3] * w[c][3]; }
#pragma unroll
        for (int o = 32; o >= 1; o >>= 1) { ss += __shfl_xor(ss, o); st += __shfl_xor(st, o); }
        const float rs = 1.0f / sqrtf(ss * (1.0f / D) + EPS), rt = 1.0f / sqrtf(st * (1.0f / D) + EPS);
#pragma unroll
        for (int c = 0; c < 8; ++c) { const f32x4 gg = *(const f32x4*)(g + (c * 64 + lane) * 4); const f32x4 y = v[c] * rs * gg, z = w[c] * rt * gg;
            if (OUT_BF16) { *(u32x2*)((bf16_t*)out + (size_t)r * D + (c * 64 + lane) * 4) = pack4(y); if (two) *(u32x2*)((bf16_t*)out + (size_t)r2 * D + (c * 64 + lane) * 4) = pack4(z); }
            else { *(f32x4*)((float*)out + (size_t)r * D + (c * 64 + lane) * 4) = y; if (two) *(f32x4*)((float*)out + (size_t)r2 * D + (c * 64 + lane) * 4) = z; } }
    }
}

template <bool OUT_BF16>
__device__ __forceinline__ void rmsnorm_rows_b(const bf16_t* x, const float* g, void* out, int nrows, int wave0, int nwaves, int lane, unsigned char* out8 = nullptr) {
    for (int r = wave0; r < nrows; r += 2 * nwaves) {
        const int r2 = r + nwaves; const bool two = r2 < nrows;
        const bf16_t* xr = x + (size_t)r * D; const bf16_t* xq = x + (size_t)(two ? r2 : r) * D; u32x4 v[4], w[4]; float ss = 0.f, st = 0.f;
#pragma unroll
        for (int c = 0; c < 4; ++c) v[c] = *(const u32x4*)(xr + (c * 64 + lane) * 8);
#pragma unroll
        for (int c = 0; c < 4; ++c) w[c] = *(const u32x4*)(xq + (c * 64 + lane) * 8);
        f32x4 a[4][2], b[4][2];
#pragma unroll
        for (int c = 0; c < 4; ++c) { a[c][0] = (f32x4){bf_lo(v[c].x), bf_hi(v[c].x), bf_lo(v[c].y), bf_hi(v[c].y)}; a[c][1] = (f32x4){bf_lo(v[c].z), bf_hi(v[c].z), bf_lo(v[c].w), bf_hi(v[c].w)};
            b[c][0] = (f32x4){bf_lo(w[c].x), bf_hi(w[c].x), bf_lo(w[c].y), bf_hi(w[c].y)}; b[c][1] = (f32x4){bf_lo(w[c].z), bf_hi(w[c].z), bf_lo(w[c].w), bf_hi(w[c].w)};
#pragma unroll
            for (int k = 0; k < 2; ++k) { ss += a[c][k][0] * a[c][k][0] + a[c][k][1] * a[c][k][1] + a[c][k][2] * a[c][k][2] + a[c][k][3] * a[c][k][3];
                st += b[c][k][0] * b[c][k][0] + b[c][k][1] * b[c][k][1] + b[c][k][2] * b[c][k][2] + b[c][k][3] * b[c][k][3]; } }
#pragma unroll
        for (int o = 32; o >= 1; o >>= 1) { ss += __shfl_xor(ss, o); st += __shfl_xor(st, o); }
        const float rs = 1.0f / sqrtf(ss * (1.0f / D) + EPS), rt = 1.0f / sqrtf(st * (1.0f / D) + EPS);
#pragma unroll
        for (int c = 0; c < 4; ++c) { const int e0 = (c * 64 + lane) * 8; const f32x4 g0 = *(const f32x4*)(g + e0), g1 = *(const f32x4*)(g + e0 + 4);
            const f32x4 y0 = a[c][0] * rs * g0, y1 = a[c][1] * rs * g1, z0 = b[c][0] * rt * g0, z1 = b[c][1] * rt * g1;
            if (OUT_BF16) { *(u32x4*)((bf16_t*)out + (size_t)r * D + e0) = pack8(y0, y1); if (two) *(u32x4*)((bf16_t*)out + (size_t)r2 * D + e0) = pack8(z0, z1);
                if (out8) { u32x2 q; q.x = pk_fp8x4(y0); q.y = pk_fp8x4(y1); *(u32x2*)(out8 + (size_t)r * D + e0) = q; if (two) { u32x2 q2; q2.x = pk_fp8x4(z0); q2.y = pk_fp8x4(z1); *(u32x2*)(out8 + (size_t)r2 * D + e0) = q2; } } }
            else { float* o1 = (float*)out + (size_t)r * D + e0; *(f32x4*)o1 = y0; *(f32x4*)(o1 + 4) = y1;
                   if (two) { float* o2 = (float*)out + (size_t)r2 * D + e0; *(f32x4*)o2 = z0; *(f32x4*)(o2 + 4) = z1; } } }
    }
}

__device__ __forceinline__ int rope_slot(int d) { const int n = d >> 6, dd = d & 63; return 32 * (dd >> 4) + 16 * n + (dd & 15); }
__device__ __forceinline__ int slot_of(int mode, int c) {
    switch (mode) {
    case 0: return c;
    case 1: return permb(c);
    case 2: if (c < 1024) return permb(c);
            if (c < 2560) { const int x = c - 1024; return 1024 + (x & ~127) + rope_slot(x & 127); }
            if (c < 4096) { const int x = c - 2560; return 2560 + (x & ~127) + rope_slot(x & 127); }
            if (c < 5632) return 5120 + (c - 4096);
            if (c < 6656) return 4096 + permb(c - 5632);
            return 6656 + permb(c - 6656);
    case 3: return 256 * (c >> 7) + permb(c & 127);
    case 4: return 256 * (c >> 7) + 128 + permb(c & 127);
    default: return c < 1024 ? permb(c) : c;
    }
}
__device__ __forceinline__ void cvt_matrix(LAS unsigned char* lds, const float* src, int Ks, int Ns, bf16_t* dst, int mode, int& rot, int bid, int G, int tid, int wave, int lane) {
    const int nkt = Ks / 64, ntiles = nkt * (Ns / 256);
    int t = (bid + G - rot) % G; rot = (rot + ntiles) % G; if (t >= ntiles) return;
    float v[8][4];
    { const int kt = t % nkt, cn = t / nkt; const float* p = src + (size_t)(kt * 64 + wave * 8) * Ns + cn * 256 + lane;
#pragma unroll
      for (int i = 0; i < 8; ++i)
#pragma unroll
          for (int j = 0; j < 4; ++j) v[i][j] = p[(size_t)i * Ns + 64 * j]; }
    for (;;) {
        const int kt = t % nkt, cn = t / nkt;
#pragma unroll
        for (int j = 0; j < 4; ++j) { u32x4 w; w.x = cvt_pk_bf16(v[0][j], v[1][j]); w.y = cvt_pk_bf16(v[2][j], v[3][j]); w.z = cvt_pk_bf16(v[4][j], v[5][j]); w.w = cvt_pk_bf16(v[6][j], v[7][j]);
            *(LAS u32x4*)(lds + (lane + 64 * j) * 144 + wave * 16) = w; }
        const int tn = t + G;
        if (tn < ntiles) { const int kt2 = tn % nkt, cn2 = tn / nkt; const float* p = src + (size_t)(kt2 * 64 + wave * 8) * Ns + cn2 * 256 + lane;
#pragma unroll
            for (int i = 0; i < 8; ++i)
#pragma unroll
                for (int j = 0; j < 4; ++j) v[i][j] = p[(size_t)i * Ns + 64 * j]; }
        __syncthreads();
#pragma unroll
        for (int p_ = 0; p_ < 4; ++p_) { const int n = p_ * 64 + (tid >> 3), ch = tid & 7;
            const u32x4 w = *(const LAS u32x4*)(lds + n * 144 + ch * 16);
            *(u32x4*)(dst + (size_t)slot_of(mode, cn * 256 + n) * Ks + kt * 64 + ch * 8) = w; }
        __syncthreads();
        if (tn >= ntiles) break;
        t = tn;
    }
}

__device__ __forceinline__ void attn_tile(const bf16_t* q, const bf16_t* k, const bf16_t* vt, bf16_t* og, float* lse, int T, int lane) {
    const int fr = lane & 15, fq = lane >> 4;
    const int g = T >> 12, Tp = T & 4095, hg = Tp >> 10, Tpp = Tp & 1023;
    const int dsh = 2 * g, d = 1 << dsh, per = 1024 >> dsh, r = Tpp >> (10 - dsh), lb = Tpp & (per - 1), l0 = lb * 16, L = S >> dsh, L8 = L >> 3;
    const int head = g * 4 + hg, lstart = l0 - 64;
    bf16x8 qf[4];
    const int tok = (l0 + fr) * d + r;
    { const bf16_t* p = q + (size_t)tok * 1536 + head * 128 + fq * 8;
#pragma unroll
      for (int kk = 0; kk < 4; ++kk) qf[kk] = *(const bf16x8*)(p + kk * 32); }
    const bf16_t* kbase = k + head * 128 + fq * 8;
    bf16x8 kf[10][4];
#pragma unroll
    for (int kb = 0; kb < 10; ++kb) { int lk = lstart + 32 * (kb >> 1) + 8 * (fr >> 2) + 4 * (kb & 1) + (fr & 3); lk = lk < 0 ? 0 : (lk > L - 1 ? L - 1 : lk);
        const bf16_t* kp = kbase + (size_t)(lk * d + r) * 1536;
#pragma unroll
        for (int kk = 0; kk < 4; ++kk) kf[kb][kk] = *(const bf16x8*)(kp + kk * 32); }
    f32x4 st[10];
#pragma unroll
    for (int kb = 0; kb < 10; ++kb) { f32x4 a = (f32x4){0.f, 0.f, 0.f, 0.f};
#pragma unroll
        for (int kk = 0; kk < 4; ++kk) a = __builtin_amdgcn_mfma_f32_16x16x32_bf16(kf[kb][kk], qf[kk], a, 0, 0, 0);
        st[kb] = a; }
    const bf16_t* vg = vt + (size_t)g * (4 * (size_t)S * 128) + ((size_t)(hg * d + r) * L8) * 1024 + fr * 8;
    bf16x8 vf[5][8];
#pragma unroll
    for (int ks = 0; ks < 5; ++ks) { int tb = (lstart + 32 * ks + 8 * fq) >> 3; tb = tb < 0 ? 0 : (tb > L8 - 1 ? L8 - 1 : tb); const bf16_t* vp = vg + (size_t)tb * 1024;
#pragma unroll
        for (int db = 0; db < 8; ++db) vf[ks][db] = *(const bf16x8*)(vp + db * 128); }
    float m_ = -3.0e38f;
#pragma unroll
    for (int kb = 0; kb < 10; ++kb)
#pragma unroll
        for (int j = 0; j < 4; ++j) { const int kidx = 32 * (kb >> 1) + 8 * fq + 4 * (kb & 1) + j, lk = lstart + kidx, rel = kidx - 64 - fr;
            const bool ok = (lk >= 0) && (lk < L) && (rel >= -64) && (rel <= 64);
            const float s_ = ok ? st[kb][j] : -3.0e38f; st[kb][j] = s_; m_ = fmaxf(m_, s_); }
    m_ = fmaxf(m_, __shfl_xor(m_, 16)); m_ = fmaxf(m_, __shfl_xor(m_, 32));
    float su = 0.f;
#pragma unroll
    for (int kb = 0; kb < 10; ++kb)
#pragma unroll
        for (int j = 0; j < 4; ++j) { const float s_ = st[kb][j]; const float p_ = s_ > -1.0e38f ? fast_exp2(s_ - m_) : 0.f; st[kb][j] = p_; su += p_; }
    su += __shfl_xor(su, 16); su += __shfl_xor(su, 32);
    f32x4 o[8];
#pragma unroll
    for (int db = 0; db < 8; ++db) o[db] = (f32x4){0.f, 0.f, 0.f, 0.f};
#pragma unroll
    for (int ks = 0; ks < 5; ++ks) { const u32x4 w = pack8(st[2 * ks], st[2 * ks + 1]); const bf16x8 pf = __builtin_bit_cast(bf16x8, w);
#pragma unroll
        for (int db = 0; db < 8; ++db) o[db] = __builtin_amdgcn_mfma_f32_16x16x32_bf16(vf[ks][db], pf, o[db], 0, 0, 0); }
    const float inv = 1.0f / su;
    bf16_t* op = og + ((size_t)g * S + tok) * 512 + hg * 128 + 4 * fq;
#pragma unroll
    for (int db = 0; db < 8; ++db) *(u32x2*)(op + db * 16) = pack4(o[db] * inv);
    if (fq == 0) lse[((size_t)g * S + tok) * 4 + hg] = m_ + __log2f(su);
}

__device__ __forceinline__ void mem_unit(LAS unsigned char* lds, const bf16_t* qm, const bf16_t* kmk, const bf16_t* vmt, bf16_t* mo, unsigned char* mo8, int unit, int tid, int wave, int lane) {
    const int fr = lane & 15, fq = lane >> 4;
    const int hm = unit >> 7, tok = (unit & 127) * 128 + wave * 16 + fr;
#pragma unroll 4
    for (int i = 0; i < 16; ++i) { const int ch = tid + i * 512, row = ch >> 5, c = ch & 31;
        const u32x4 w = *(const u32x4*)(kmk + (size_t)row * 1024 + hm * 256 + c * 8);
        *(LAS u32x4*)(lds + row * 512 + ((c ^ ((row & 3) | (((row >> 3) & 3) << 2))) << 4)) = w; }
    bf16x8 qf[8];
    { const bf16_t* p = qm + (size_t)tok * 1024 + hm * 256 + fq * 8;
#pragma unroll
      for (int kk = 0; kk < 8; ++kk) qf[kk] = *(const bf16x8*)(p + kk * 32); }
    __syncthreads();
    bf16x8 pf[8];
    { const int krow0 = 8 * (fr >> 2) + (fr & 3), key4 = fr;
        f32x4 st[16];
#pragma unroll
        for (int kb = 0; kb < 16; ++kb) { const int row = 32 * (kb >> 1) + 4 * (kb & 1) + krow0; f32x4 a = (f32x4){0.f, 0.f, 0.f, 0.f};
#pragma unroll
            for (int kk = 0; kk < 8; ++kk) { const bf16x8 kf = *(const LAS bf16x8*)(lds + row * 512 + (((kk * 4 + fq) ^ key4) << 4));
                a = __builtin_amdgcn_mfma_f32_16x16x32_bf16(kf, qf[kk], a, 0, 0, 0); }
            st[kb] = a; }
        float m_ = -3.0e38f;
#pragma unroll
        for (int kb = 0; kb < 16; ++kb)
#pragma unroll
            for (int j = 0; j < 4; ++j) m_ = fmaxf(m_, st[kb][j]);
        m_ = fmaxf(m_, __shfl_xor(m_, 16)); m_ = fmaxf(m_, __shfl_xor(m_, 32));
        float su = 0.f;
#pragma unroll
        for (int kb = 0; kb < 16; ++kb)
#pragma unroll
            for (int j = 0; j < 4; ++j) { const float p_ = fast_exp2(st[kb][j] - m_); st[kb][j] = p_; su += p_; }
        su += __shfl_xor(su, 16); su += __shfl_xor(su, 32);
        const float inv = 1.0f / su;
#pragma unroll
        for (int ks = 0; ks < 8; ++ks) { const u32x4 w = pack8(st[2 * ks] * inv, st[2 * ks + 1] * inv); pf[ks] = __builtin_bit_cast(bf16x8, w); }
    }
    __syncthreads();
#pragma unroll 4
    for (int i = 0; i < 16; ++i) { const int ch = tid + i * 512;
        *(LAS u32x4*)(lds + ch * 16) = *(const u32x4*)(vmt + (size_t)hm * 65536 + (size_t)ch * 8); }
    __syncthreads();
    bf16_t* op = mo + (size_t)tok * 1024 + hm * 256 + 4 * fq;
#pragma unroll
    for (int db = 0; db < 16; ++db) { f32x4 a = (f32x4){0.f, 0.f, 0.f, 0.f};
#pragma unroll
        for (int ks = 0; ks < 8; ++ks) { const bf16x8 vf = *(const LAS bf16x8*)(lds + (((4 * ks + fq) * 256 + 16 * db + fr) << 4));
            a = __builtin_amdgcn_mfma_f32_16x16x32_bf16(vf, pf[ks], a, 0, 0, 0); }
        *(unsigned*)(mo8 + (size_t)tok * 1024 + hm * 256 + 4 * fq + db * 16) = pk_fp8x4(a * 16.0f); }
    __syncthreads();
}

template <int HW> __device__ __forceinline__ void pool_chunk(const bf16_t* u, bf16_t* pooled, int s0, int c) {
#pragma unroll 1
    for (int blk = 0; blk < 8; ++blk) { const int sb = s0 + blk * 8;
        float v0[8 + 2 * HW], v1[8 + 2 * HW];
#pragma unroll
        for (int i = 0; i < 8 + 2 * HW; ++i) { const int j = sb - HW + i; const bool ok = (j >= 0) && (j < S); const int jc = ok ? j : sb;
            const unsigned w = *(const unsigned*)(u + (size_t)jc * 1024 + c); v0[i] = ok ? bf_lo(w) : 0.f; v1[i] = ok ? bf_hi(w) : 0.f; }
        float a0 = 0.f, a1 = 0.f;
#pragma unroll
        for (int i = 0; i < 2 * HW; ++i) { a0 += v0[i]; a1 += v1[i]; }
#pragma unroll
        for (int i = 0; i < 8; ++i) { const int s_ = sb + i; a0 += v0[i + 2 * HW]; a1 += v1[i + 2 * HW];
            const int hi_ = s_ + HW + 1 < S ? s_ + HW + 1 : S, lo_ = s_ - HW > 0 ? s_ - HW : 0; const float ic = 1.0f / (float)(hi_ - lo_);
            *(unsigned*)(pooled + (size_t)s_ * 1024 + c) = cvt_pk_bf16(a0 * ic - v0[i + HW], a1 * ic - v1[i + HW]);
            a0 -= v0[i]; a1 -= v1[i]; }
    }
}


#define XB_TMO      128
#define XB_XCNT(j)  (256  + 64 * (j))
#define XB_XSUB(j)  (1280 + 64 * (j))
#define XB_XGEN(j)  (2304 + 64 * (j))
#define XB_TOP      3328
#define XB_TOPGEN   3392
#define XCD_BAR_WORDS 3456
#define XB_SPIN_CAP (1u << 18)

__device__ __forceinline__ unsigned xb_ld(unsigned* p)              { return __hip_atomic_load(p, __ATOMIC_RELAXED, __HIP_MEMORY_SCOPE_AGENT); }
__device__ __forceinline__ unsigned xb_add(unsigned* p, unsigned v) { return __hip_atomic_fetch_add(p, v, __ATOMIC_RELAXED, __HIP_MEMORY_SCOPE_AGENT); }
__device__ __forceinline__ unsigned xb_xcc_id() { return (unsigned)__builtin_amdgcn_s_getreg((3 << 11) | 20) & 0xFu; }
#define XB_SPIN(cond, bar) do { unsigned _sp = 0; while (cond) { __builtin_amdgcn_s_sleep(1); \
    if ((++_sp & 255u) == 0u) { if (xb_ld(&(bar)[XB_TMO])) break; if (_sp > XB_SPIN_CAP) { atomicAdd(&(bar)[XB_TMO], 1u); break; } } } } while (0)

struct XcdBarrier {
    unsigned* bar; unsigned x;
    volatile LAS unsigned* st;
};

__device__ __forceinline__ XcdBarrier xcd_barrier_post(unsigned* bar, volatile LAS unsigned* st) {
    XcdBarrier b; b.bar = bar; b.x = xb_xcc_id(); b.st = st;
    if (threadIdx.x == 0) (void)xb_add(&bar[XB_XCNT(b.x)], 1u);
    return b;
}
__device__ __forceinline__ void xcd_barrier_complete(unsigned* bar, unsigned x, unsigned& nloc, unsigned& nx) {
    const unsigned G = gridDim.x * gridDim.y * gridDim.z;
    unsigned sum, cnt, mine, sp = 0u;
    for (;;) {
        sum = 0u; cnt = 0u; mine = 0u;
#pragma unroll
        for (unsigned j = 0; j < 16; ++j) { const unsigned c = xb_ld(&bar[XB_XCNT(j)]); sum += c; cnt += (c > 0u) ? 1u : 0u; mine = (j == x) ? c : mine; }
        if (sum == G) break;
        __builtin_amdgcn_s_sleep(1);
        if ((++sp & 255u) == 0u) { if (xb_ld(&bar[XB_TMO])) break; if (sp > XB_SPIN_CAP) { atomicAdd(&bar[XB_TMO], 1u); break; } }
    }
    nloc = mine > 0u ? mine : 1u; nx = cnt > 0u ? cnt : 1u;
}

__device__ __forceinline__ void xcd_barrier(const XcdBarrier& b, const bool t0) {
    asm volatile("s_waitcnt vmcnt(0)" ::: "memory");
    __syncthreads();
    if (t0) {
        unsigned* bar = b.bar;
        __builtin_amdgcn_s_waitcnt(0);
        unsigned nloc = b.st[0], nx = b.st[1];
        if (nloc == 0u) { xcd_barrier_complete(bar, b.x, nloc, nx); b.st[0] = nloc; b.st[1] = nx; }
        const unsigned old = xb_add(&bar[XB_XSUB(b.x)], 1u);
        const unsigned gen = old / nloc;
        if (old + 1u == (gen + 1u) * nloc) {
            __builtin_amdgcn_fence(__ATOMIC_RELEASE, "agent");
            asm volatile("s_waitcnt vmcnt(0)" ::: "memory");
            const unsigned og = xb_add(&bar[XB_TOP], 1u);
            const unsigned tg = og / nx;
            if (og + 1u == (tg + 1u) * nx) xb_add(&bar[XB_TOPGEN], 1u);
            else XB_SPIN(xb_ld(&bar[XB_TOPGEN]) == tg, bar);
            __builtin_amdgcn_fence(__ATOMIC_ACQUIRE, "agent");
            xb_add(&bar[XB_XGEN(b.x)], 1u);
            asm volatile("s_waitcnt vmcnt(0)" ::: "memory");
        } else {
            XB_SPIN(xb_ld(&bar[XB_XGEN(b.x)]) == gen, bar);
            __builtin_amdgcn_fence(__ATOMIC_ACQUIRE, "agent");
            asm volatile("s_waitcnt vmcnt(0)" ::: "memory");
        }
    }
    __syncthreads();
}


__device__ __forceinline__ void cvt_bf16_fp8(const bf16_t* src, unsigned char* dst, int nitems, int i0, int stride) {
    for (int i = i0; i < nitems; i += 4 * stride) { u32x4 w[4];
#pragma unroll
        for (int j = 0; j < 4; ++j) { const int k = i + j * stride; w[j] = *(const u32x4*)(src + (size_t)(k < nitems ? k : i) * 8); }
#pragma unroll
        for (int j = 0; j < 4; ++j) { const int k = i + j * stride;
            const f32x4 a0 = (f32x4){bf_lo(w[j].x), bf_hi(w[j].x), bf_lo(w[j].y), bf_hi(w[j].y)} * 64.0f, a1 = (f32x4){bf_lo(w[j].z), bf_hi(w[j].z), bf_lo(w[j].w), bf_hi(w[j].w)} * 64.0f;
            u32x2 q; q.x = pk_fp8x4(a0); q.y = pk_fp8x4(a1); if (k < nitems) *(u32x2*)(dst + (size_t)k * 8) = q; } }
}

struct Args {
    const float* x; const float* mem; const int* pos;
    const float *f1n, *f1g, *f1u, *f1d, *mixn, *win, *bgate, *poolw, *pools, *memn, *wkv, *wupp, *wupa, *wupm, *wout, *f2n, *f2g, *f2u, *f2d, *finn;
    float* out; unsigned char* ws; int ph_lo, ph_hi;
};
constexpr int NPH = 12;
constexpr int LDS_TOTAL = STAGE_BYTES + 64;
template <class T> __device__ __forceinline__ T arg_ld(const void* base, int off) { asm volatile("" : "+s"(off)); return *(const T*)((const char*)base + off); }
#define ARG(f) arg_ld<decltype(Args::f)>(&a, (int)offsetof(Args, f))


__global__ void __launch_bounds__(512, 2) fwd_kernel(Args a) {
    extern __shared__ __attribute__((aligned(16))) unsigned char lds_raw[];
    LAS unsigned char* lds = (LAS unsigned char*)lds_raw;
    volatile LAS unsigned* bst = (volatile LAS unsigned*)(lds + STAGE_BYTES);
    if (threadIdx.x < 2) bst[threadIdx.x] = 0u;
    __syncthreads();
    const int wave = __builtin_amdgcn_readfirstlane(threadIdx.x >> 6);
    if (ARG(ph_lo) < 0) cg::this_grid().sync();
#define lane lane_id()
#define tid (wave * 64 + lane_id())
    const int G = gridDim.x, bid = blockIdx.x, gw = bid * 8 + wave, nw = G * 8;
    unsigned char* const ws = ARG(ws);
    XcdBarrier xbar; xbar.bar = (unsigned*)(ws + WS_BAR); xbar.x = 0; xbar.st = bst;
    if (ARG(ph_hi) - ARG(ph_lo) > 1) xbar = xcd_barrier_post((unsigned*)(ws + WS_BAR), bst);
#define P_Wgu    ((bf16_t*)(ws + WS_WA))
#define P_Wd     ((bf16_t*)(ws + WS_WA + 44 * MiB))
#define P_og     ((bf16_t*)(ws + WS_WA))
#define P_ao     ((bf16_t*)(ws + WS_WA + 48 * MiB))
#define P_Win    ((bf16_t*)(ws + WS_WIN))
#define P_Wkv    ((bf16_t*)(ws + WS_WKV))
#define P_Wupp   ((bf16_t*)(ws + WS_WUPP))
#define P_Wupa   ((bf16_t*)(ws + WS_WUPA))
#define P_Wupm   ((bf16_t*)(ws + WS_WUPM))
#define P_Wout   ((bf16_t*)(ws + WS_WOUT))
#define P_Wpool  ((bf16_t*)(ws + WS_WPOOL))
#define P_act    ((bf16_t*)(ws + WS_R2))
#define P_ub     ((bf16_t*)(ws + WS_R2))
#define P_qb_    ((bf16_t*)(ws + WS_R2 + 32 * MiB))
#define P_kb_    ((bf16_t*)(ws + WS_R2 + 80 * MiB))
#define P_vtb    ((bf16_t*)(ws + WS_R2 + 128 * MiB))
#define P_qmb    ((bf16_t*)(ws + WS_R2 + 176 * MiB))
#define P_gates  ((bf16_t*)(ws + WS_R2))
#define P_h      ((bf16_t*)(ws + WS_R3))
#define P_merged ((bf16_t*)(ws + WS_R3))
#define P_pooled ((bf16_t*)(ws + WS_R5))
#define P_mo     ((bf16_t*)(ws + WS_R5 + 32 * MiB))
#define P_pmb    ((bf16_t*)(ws + WS_R5 + 64 * MiB))
#define P_cs     ((float*)(ws + WS_COS))
#define P_sn     ((float*)(ws + WS_SIN))
#define P_memn   ((bf16_t*)(ws + WS_MEMN))
#define P_kmk    ((bf16_t*)(ws + WS_KVMK))
#define P_vmt    ((bf16_t*)(ws + WS_VMT))
#define P_lse    ((float*)(ws + WS_LSE))
#define P_x1b    ((bf16_t*)ARG(out))
#define P_x2b    ((bf16_t*)ARG(out) + (size_t)S * D)
#define P_h8     ((unsigned char*)ARG(out) + 64 * MiB)
#define P_ao8    ((unsigned char*)ARG(out) + 96 * MiB)
#define P_mo8    ((unsigned char*)ARG(out) + 104 * MiB)
#define P_Wupa8  ((unsigned char*)ARG(out) + 120 * MiB)
#define P_Wupm8  ((unsigned char*)ARG(out) + 121 * MiB)
#define P_Wg8    ((unsigned char*)(ws + WS_WG8))
#define P_W8b    ((unsigned char*)(ws + WS_W8B))
#define P_x3b    ((bf16_t*)(ws + WS_R3))
#define IN(p) (ARG(ph_lo) <= (p) && (p) < ARG(ph_hi))
#define PHASE_REP(p) for (int rep_ = 0; rep_ < ((p) == PROBE_PH ? 2 : 1); ++rep_)
#define REPSYNC do { if (rep_ > 0) xcd_barrier(xbar, wave == 0 && lane_id() == 0); } while (0)
#define SEAM(p) do { if (ARG(ph_lo) <= (p) && (p) + 1 < ARG(ph_hi)) { xcd_barrier(xbar, wave == 0 && lane_id() == 0); } } while (0)

    if (IN(0)) PHASE_REP(0) { REPSYNC;
        int rot = 0;
        cvt_matrix(lds, ARG(f1g), D, FF, P_Wgu, 3, rot, bid, G, tid, wave, lane);
        cvt_matrix(lds, ARG(f1u), D, FF, P_Wgu, 4, rot, bid, G, tid, wave, lane);
        cvt_matrix(lds, ARG(f1d), FF, D, P_Wd, 1, rot, bid, G, tid, wave, lane);
        cvt_matrix(lds, ARG(win), D, INC, P_Win, 2, rot, bid, G, tid, wave, lane);
        cvt_matrix(lds, ARG(wkv), D, 2048, P_Wkv, 5, rot, bid, G, tid, wave, lane);
        cvt_matrix(lds, ARG(wupp), 1024, D, P_Wupp, 1, rot, bid, G, tid, wave, lane);
        cvt_matrix(lds, ARG(wupa), 512, D, P_Wupa, 1, rot, bid, G, tid, wave, lane);
        cvt_matrix(lds, ARG(wupm), 1024, D, P_Wupm, 1, rot, bid, G, tid, wave, lane);
        cvt_matrix(lds, ARG(wout), D, D, P_Wout, 1, rot, bid, G, tid, wave, lane);
        for (int gp = 0; gp < 4; ++gp) cvt_matrix(lds, ARG(poolw) + gp * 65536, 256, 256, P_Wpool + gp * 65536, 1, rot, bid, G, tid, wave, lane);
        for (int i = bid * 512 + tid; i < S * 64; i += G * 512) { const int s_ = i >> 6, f = i & 63;
            const float inv = powf(10000.0f, -(float)f / 64.0f); const float ang = (float)ARG(pos)[s_] * inv; float sv, cv; sincosf(ang, &sv, &cv); P_cs[i] = cv; P_sn[i] = sv; }
        rmsnorm_rows<true>(ARG(x), ARG(f1n), P_h, S, gw, nw, lane);
        rmsnorm_rows<true>(ARG(mem), ARG(memn), P_memn, NMEM, gw, nw, lane);
    }
    SEAM(0);
    if (IN(1)) PHASE_REP(1) { REPSYNC;
        Gemm g{P_h, P_Wgu, D, D, S, 2 * FF, D}; StaticOrder so; so.init(S, 2 * FF, G, bid);
        gemm_phase<EpiGU, 0>(lds, g, so, EpiGU{P_act}, wave);
    }
    SEAM(1);
    if (IN(2)) PHASE_REP(2) { REPSYNC;
        Gemm g{P_act, P_Wd, FF, FF, S, D, FF}; StaticOrder so; so.init(S, D, G, bid);
        gemm_phase<EpiResB<true>, 0>(lds, g, so, EpiResB<true>{ARG(x), P_x1b, 0.5f, 0}, wave);
    }
    SEAM(2);
    if (IN(3)) PHASE_REP(3) { REPSYNC;
        {
            const int t0 = bid * 512 + tid, ts = G * 512;
            cvt_bf16_fp8(P_Win + (size_t)6656 * D, P_Wg8, 6144 * D / 8, t0, ts);
            cvt_bf16_fp8(P_Win + (size_t)1024 * D, P_W8b, 5632 * D / 8, t0, ts);
            cvt_bf16_fp8(P_Wupa, P_Wupa8, 512 * D / 8, t0, ts);
            cvt_bf16_fp8(P_Wupm, P_Wupm8, 1024 * D / 8, t0, ts);
        }
        rmsnorm_rows_b<true>(P_x1b, ARG(mixn), P_h, S, gw, nw, lane, P_h8);
    }
    SEAM(3);
    if (IN(4)) PHASE_REP(4) { REPSYNC;
        { Gemm g{P_h, P_Win, D, D, S, 1024, D}; StaticOrder so; so.init(S, 1024, G, bid);
          gemm_phase<EpiProj, 0>(lds, g, so, EpiProj{P_ub, P_qb_, P_kb_, P_qmb, P_cs, P_sn, 0.f, 0.f, 0.f, 0}, wave); }
        { Gemm g{(const bf16_t*)P_h8, (const bf16_t*)P_W8b, D / 2, D / 2, S, 4096, D / 2}; StaticOrder so; so.init(S, 4096, G, bid);
          gemm_phase<EpiProj, 0, true>(lds, g, so, EpiProj{P_ub, P_qb_, P_kb_, P_qmb, P_cs, P_sn, LOG2E * 0.08838834764831845f / 64.0f, LOG2E * 0.0625f / 64.0f, 1.0f / 64.0f, 4}, wave); }
        const int G2 = G / 2; const bf16_t* const wv8 = (const bf16_t*)(P_W8b + (size_t)4096 * D);
        if (bid < G2) { Gemm g{wv8, (const bf16_t*)P_h8, D / 2, D / 2, 512, S, D / 2}; StaticOrder so; so.init(512, S, G2, bid); gemm_phase<EpiVt<1>, 1, true>(lds, g, so, EpiVt<1>{P_vtb, 1.0f / 64.0f, 0}, wave); }
        else { Gemm g{wv8 + (size_t)512 * (D / 2), (const bf16_t*)P_h8, D / 2, D / 2, 512, S, D / 2}; StaticOrder so; so.init(512, S, G - G2, bid - G2); gemm_phase<EpiVt<4>, 4, true>(lds, g, so, EpiVt<4>{P_vtb + (size_t)4 * S * 128, 1.0f / 64.0f, 0}, wave); }
        if (bid < G2) { Gemm g{wv8 + (size_t)1024 * (D / 2), (const bf16_t*)P_h8, D / 2, D / 2, 512, S, D / 2}; StaticOrder so; so.init(512, S, G2, bid); gemm_phase<EpiVt<16>, 16, true>(lds, g, so, EpiVt<16>{P_vtb + (size_t)8 * S * 128, 1.0f / 64.0f, 0}, wave); }
        else if (bid - G2 < 4) { Gemm g{P_memn, P_Wkv, D, D, NMEM, 1024, D}; StaticOrder so; so.init(NMEM, 1024, 4, bid - G2); gemm_phase<EpiKvmK, 0>(lds, g, so, EpiKvmK{P_kmk}, wave); }
        else if (bid - G2 < 8) { Gemm g{P_Wkv + (size_t)1024 * D, P_memn, D, D, 1024, NMEM, D}; StaticOrder so; so.init(1024, NMEM, 4, bid - G2 - 4); gemm_phase<EpiKvmVt, 1>(lds, g, so, EpiKvmVt{P_vmt}, wave); }
    }
    SEAM(4);
    if (IN(5)) PHASE_REP(5) { REPSYNC;
        for (int T = gw; T < 12288 * DBG_ATT; T += nw) attn_tile(P_qb_, P_kb_, P_vtb, P_og, P_lse, T, lane);
        for (int un = bid; un < 512; un += G) mem_unit(lds, P_qmb, P_kmk, P_vmt, P_mo, P_mo8, un, tid, wave, lane);
        {
            const int gp = wave >> 1;
            for (int c0 = bid; c0 < S / 64; c0 += G) {
                if (gp == 0) pool_chunk<1>(P_ub, P_pooled, c0 * 64, 2 * tid);
                else if (gp == 1) pool_chunk<2>(P_ub, P_pooled, c0 * 64, 2 * tid);
                else if (gp == 2) pool_chunk<4>(P_ub, P_pooled, c0 * 64, 2 * tid);
                else pool_chunk<8>(P_ub, P_pooled, c0 * 64, 2 * tid);
            }
        }
    }
    SEAM(5);
    if (IN(6)) PHASE_REP(6) { REPSYNC;
        for (int i0 = bid * 512 + tid; i0 < S * 64; i0 += 4 * G * 512) {
            float l_[4][3]; u32x4 x_[4][3];
#pragma unroll
            for (int j = 0; j < 4; ++j) { const int ij = i0 + j * G * 512, i = ij < S * 64 ? ij : i0; const int t = i >> 6, col = (i & 63) * 8, hg = col >> 7;
#pragma unroll
                for (int g_ = 0; g_ < 3; ++g_) { l_[j][g_] = P_lse[((size_t)g_ * S + t) * 4 + hg]; x_[j][g_] = *(const u32x4*)(P_og + ((size_t)g_ * S + t) * 512 + col); } }
#pragma unroll
            for (int j = 0; j < 4; ++j) { const int i = i0 + j * G * 512; const int t = i >> 6, col = (i & 63) * 8;
                const float l0_ = l_[j][0], l1_ = l_[j][1], l2_ = l_[j][2]; const u32x4 x0 = x_[j][0], x1 = x_[j][1], x2 = x_[j][2];
                const float mm = fmaxf(l0_, fmaxf(l1_, l2_)); float w0 = fast_exp2(l0_ - mm), w1 = fast_exp2(l1_ - mm), w2 = fast_exp2(l2_ - mm); const float iw = 1.0f / (w0 + w1 + w2); w0 *= iw; w1 *= iw; w2 *= iw;
                u32x4 o_;
                o_.x = cvt_pk_bf16(w0 * bf_lo(x0.x) + w1 * bf_lo(x1.x) + w2 * bf_lo(x2.x), w0 * bf_hi(x0.x) + w1 * bf_hi(x1.x) + w2 * bf_hi(x2.x));
                o_.y = cvt_pk_bf16(w0 * bf_lo(x0.y) + w1 * bf_lo(x1.y) + w2 * bf_lo(x2.y), w0 * bf_hi(x0.y) + w1 * bf_hi(x1.y) + w2 * bf_hi(x2.y));
                o_.z = cvt_pk_bf16(w0 * bf_lo(x0.z) + w1 * bf_lo(x1.z) + w2 * bf_lo(x2.z), w0 * bf_hi(x0.z) + w1 * bf_hi(x1.z) + w2 * bf_hi(x2.z));
                o_.w = cvt_pk_bf16(w0 * bf_lo(x0.w) + w1 * bf_lo(x1.w) + w2 * bf_lo(x2.w), w0 * bf_hi(x0.w) + w1 * bf_hi(x1.w) + w2 * bf_hi(x2.w));
                const f32x4 a0 = (f32x4){bf_lo(o_.x), bf_hi(o_.x), bf_lo(o_.y), bf_hi(o_.y)} * 16.0f, a1 = (f32x4){bf_lo(o_.z), bf_hi(o_.z), bf_lo(o_.w), bf_hi(o_.w)} * 16.0f;
                u32x2 q; q.x = pk_fp8x4(a0); q.y = pk_fp8x4(a1); if (i < S * 64) *(u32x2*)(P_ao8 + (size_t)t * 512 + col) = q; } }
        { const int G4 = G / 4, gp = bid / G4 < 3 ? bid / G4 : 3, c = bid - gp * G4, gn = gp < 3 ? G4 : G - 3 * G4;
          Gemm g{P_pooled + gp * 256, P_Wpool + gp * 65536, 1024, 256, S, 256, 256}; StaticOrder so; so.init(S, 256, gn, c);
          gemm_phase<EpiPm, 0>(lds, g, so, EpiPm{P_pmb, ARG(pools), gp}, wave); }
        { Gemm g{(const bf16_t*)P_h8, (const bf16_t*)P_Wg8, D / 2, D / 2, S, 3 * D, D / 2}; StaticOrder so; so.init(S, 3 * D, G, bid);
          gemm_phase<EpiGate, 0, true>(lds, g, so, EpiGate{P_gates, ARG(bgate), 1.0f / 64.0f, 0}, wave); }
    }
    SEAM(6);
    if (IN(7)) PHASE_REP(7) { REPSYNC;
        StaticOrder so; so.init(S, D, G, bid);
        { Gemm g{P_pmb, P_Wupp, 1024, 1024, S, D, 1024}; gemm_phase<EpiUp, 0>(lds, g, so, EpiUp{P_merged, P_gates, 0, 1.0f}, wave); }
        { Gemm g{(const bf16_t*)P_ao8, (const bf16_t*)P_Wupa8, 256, 256, S, D, 256}; gemm_phase<EpiUp, 0, true>(lds, g, so, EpiUp{P_merged, P_gates, 1, 1.0f / 1024.0f}, wave); }
        { Gemm g{(const bf16_t*)P_mo8, (const bf16_t*)P_Wupm8, 512, 512, S, D, 512}; gemm_phase<EpiUp, 0, true>(lds, g, so, EpiUp{P_merged, P_gates, 2, 1.0f / 1024.0f}, wave); }
    }
    SEAM(7);
    if (IN(8)) PHASE_REP(8) { REPSYNC;
        Gemm g{P_merged, P_Wout, D, D, S, D, D}; StaticOrder so; so.init(S, D, G, bid);
        gemm_phase<EpiResB<false>, 0>(lds, g, so, EpiResB<false>{P_x1b, P_x2b, 1.0f, 0}, wave);
    }
    SEAM(8);
    if (IN(9)) PHASE_REP(9) { REPSYNC;
        int rot = 0;
        cvt_matrix(lds, ARG(f2g), D, FF, P_Wgu, 3, rot, bid, G, tid, wave, lane);
        cvt_matrix(lds, ARG(f2u), D, FF, P_Wgu, 4, rot, bid, G, tid, wave, lane);
        cvt_matrix(lds, ARG(f2d), FF, D, P_Wd, 1, rot, bid, G, tid, wave, lane);
        rmsnorm_rows_b<true>(P_x2b, ARG(f2n), P_h, S, gw, nw, lane);
    }
    SEAM(9);
    if (IN(10)) PHASE_REP(10) { REPSYNC;
        Gemm g{P_h, P_Wgu, D, D, S, 2 * FF, D}; StaticOrder so; so.init(S, 2 * FF, G, bid);
        gemm_phase<EpiGU, 0>(lds, g, so, EpiGU{P_act}, wave);
    }
    SEAM(10);
    if (IN(11)) PHASE_REP(11) { REPSYNC;
        Gemm g{P_act, P_Wd, FF, FF, S, D, FF}; StaticOrder so; so.init(S, D, G, bid);
        gemm_phase<EpiResB<false>, 0>(lds, g, so, EpiResB<false>{P_x2b, P_x3b, 0.5f, 0}, wave);
    }
    SEAM(11);
    if (IN(12)) rmsnorm_rows_b<false>(P_x3b, ARG(finn), ARG(out), S, gw, nw, lane);
#undef IN
#undef SEAM
#undef lane
#undef tid
}


#ifndef DBG_UPTO
#define DBG_UPTO 12
#endif
#ifndef DBG_FOLD
#define DBG_FOLD 0
#endif
__global__ void dbg_fold(const unsigned short* w, float* out, size_t nws, int n) {
    for (int i = blockIdx.x * blockDim.x + threadIdx.x; i < n; i += gridDim.x * blockDim.x) {
        unsigned acc_ = 0; for (size_t j = (size_t)i; j < nws; j += (size_t)n) acc_ += w[j];
        out[i] = (float)acc_;
    }
}
#ifndef N_LAUNCH_MODE
#define N_LAUNCH_MODE 1
#endif

extern "C" void kernel_launch(void* const* d_in, const int* in_sizes, int n_in, void* d_out, int out_size, void* d_ws, size_t ws_size, hipStream_t stream) {
    static int grid = 0;
    if (grid == 0) {
        if (n_in != 23 || ws_size < WS_END) { fprintf(stderr, "kernel_launch: unexpected n_in %d or ws_size %zu (< %zu)\n", n_in, ws_size, (size_t)WS_END); grid = -1; return; }
        int dev = 0, cus = 0, per_cu = 0;
        hipGetDevice(&dev); hipDeviceGetAttribute(&cus, hipDeviceAttributeMultiprocessorCount, dev);
        if (hipFuncSetAttribute((const void*)fwd_kernel, hipFuncAttributeMaxDynamicSharedMemorySize, LDS_TOTAL) != hipSuccess) { fprintf(stderr, "kernel_launch: hipFuncSetAttribute failed\n"); grid = -1; return; }
        hipOccupancyMaxActiveBlocksPerMultiprocessor(&per_cu, (const void*)fwd_kernel, 512, LDS_TOTAL);
        if (per_cu < 1) { fprintf(stderr, "kernel_launch: occupancy query says %d\n", per_cu); per_cu = 1; }
        (void)hipGetLastError();
        grid = cus * 1;
    }
    if (grid < 0) return;
    if (hipMemsetAsync((char*)d_ws + WS_BAR, 0, XCD_BAR_WORDS * 4, stream) != hipSuccess) { fprintf(stderr, "kernel_launch: memset failed\n"); return; }
    Args a{};
    a.x = (const float*)d_in[0]; a.mem = (const float*)d_in[1]; a.pos = (const int*)d_in[2];
    a.f1n = (const float*)d_in[3]; a.f1g = (const float*)d_in[4]; a.f1u = (const float*)d_in[5]; a.f1d = (const float*)d_in[6];
    a.mixn = (const float*)d_in[7]; a.win = (const float*)d_in[8]; a.bgate = (const float*)d_in[9]; a.poolw = (const float*)d_in[10]; a.pools = (const float*)d_in[11];
    a.memn = (const float*)d_in[12]; a.wkv = (const float*)d_in[13]; a.wupp = (const float*)d_in[14]; a.wupa = (const float*)d_in[15]; a.wupm = (const float*)d_in[16]; a.wout = (const float*)d_in[17];
    a.f2n = (const float*)d_in[18]; a.f2g = (const float*)d_in[19]; a.f2u = (const float*)d_in[20]; a.f2d = (const float*)d_in[21]; a.finn = (const float*)d_in[22];
    a.out = (float*)d_out; a.ws = (unsigned char*)d_ws;
#if N_LAUNCH_MODE == 1
    a.ph_lo = 0; a.ph_hi = NPH + 1;
    void* args[] = {&a};
    hipError_t e = hipLaunchCooperativeKernel((const void*)fwd_kernel, dim3(grid), dim3(512), args, LDS_TOTAL, stream);
    if (e != hipSuccess) fprintf(stderr, "cooperative launch failed: %s (grid %d)\n", hipGetErrorString(e), grid);
#else
    for (int p = 0; p <= NPH && p <= DBG_UPTO; ++p) { a.ph_lo = p; a.ph_hi = p + 1; hipLaunchKernelGGL(fwd_kernel, dim3(grid), dim3(512), LDS_TOTAL, stream, a); }
#if DBG_FOLD
    hipLaunchKernelGGL(dbg_fold, dim3(2048), dim3(256), 0, stream, (const unsigned short*)d_ws, (float*)d_out, (size_t)(WS_END / 2), out_size);
#endif
#endif
}
```
